# Optimizing an MI355X kernel written in HIP

```python
import jax, jax.numpy as jnp
from jax import lax
import numpy as np

D_MODEL = 2048
BATCH = 4
SEQ = 4096
DEPTH = 2

N_MIXERS = 2
CHUNK = 128
EPS = 1e-6
GMLP_DFF = 6 * D_MODEL
GMLP_HALF = GMLP_DFF // 2
GMLP_GROUPS = 8
GMLP_GROUP_DIM = GMLP_HALF // GMLP_GROUPS
RET_HEADS = 8
RET_QK_DIM = D_MODEL
RET_V_DIM = 2 * D_MODEL
RET_HEAD_QK = RET_QK_DIM // RET_HEADS
RET_HEAD_V = RET_V_DIM // RET_HEADS
ROPE_BASE = 10000.0
FFN_DIM = 5632
CONV_WIDTH = 3

N_LAYERS_A = (DEPTH + 1) // 2
N_LAYERS_B = DEPTH // 2

kernel_name = "hybrid_gmlp_retention_convffn"


def _rms(xf):
    return xf * lax.rsqrt(jnp.mean(xf * xf, axis=-1, keepdims=True) + EPS)


def rmsnorm(x, g):
    y = _rms(x.astype(jnp.float32)) * g.astype(jnp.float32)
    return y.astype(x.dtype)


def layernorm(x, g, b):
    xf = x.astype(jnp.float32)
    mu = jnp.mean(xf, axis=-1, keepdims=True)
    xc = xf - mu
    var = jnp.mean(xc * xc, axis=-1, keepdims=True)
    y = xc * lax.rsqrt(var + EPS) * g.astype(jnp.float32) + b.astype(jnp.float32)
    return y.astype(x.dtype)


def gmlp_mixer(h, w_in, ln_g, ln_b, w_s, b_s, w_out):
    B, S, _ = h.shape
    n = S // CHUNK
    z = jax.nn.gelu(h @ w_in, approximate=False)
    u, v = jnp.split(z, 2, axis=-1)
    v = layernorm(v, ln_g, ln_b)
    v = v.reshape(B, n, CHUNK, GMLP_GROUPS, GMLP_GROUP_DIM)
    mask = jnp.tril(jnp.ones((CHUNK, CHUNK), dtype=bool))
    ws = jnp.where(mask[None], w_s, 0).astype(v.dtype)
    mixed = jnp.einsum('gts,bnsgd->bntgd', ws, v) + b_s.T.astype(v.dtype)[None, None, :, :, None]
    gated = u * mixed.reshape(B, S, GMLP_HALF)
    return gated @ w_out


def rotate_every_two(x):
    x1 = x[..., ::2]
    x2 = x[..., 1::2]
    return jnp.stack((-x2, x1), axis=-1).reshape(x.shape)


def retention_mixer(h, positions, w_in, w_out):
    B, S, _ = h.shape
    n = S // CHUNK
    dt = h.dtype
    proj = h @ w_in
    q, k, v, g = jnp.split(proj, [RET_QK_DIM, 2 * RET_QK_DIM, 2 * RET_QK_DIM + RET_V_DIM], axis=-1)
    q = q.reshape(B, S, RET_HEADS, RET_HEAD_QK)
    k = k.reshape(B, S, RET_HEADS, RET_HEAD_QK)
    v = v.reshape(B, S, RET_HEADS, RET_HEAD_V)
    inv_freq = 1.0 / (ROPE_BASE ** jnp.linspace(0.0, 1.0, RET_HEAD_QK // 2, dtype=jnp.float32))
    inv_freq = jnp.repeat(inv_freq, 2)
    ang = positions.astype(jnp.float32)[..., None] * inv_freq
    cos = jnp.cos(ang)[:, :, None, :]
    sin = jnp.sin(ang)[:, :, None, :]
    q = (q * cos + rotate_every_two(q) * sin).astype(dt)
    k = ((k * cos + rotate_every_two(k) * sin) * (RET_HEAD_QK ** -0.5)).astype(dt)
    log_gamma = jnp.log1p(-jnp.exp2(-5.0 - jnp.arange(RET_HEADS, dtype=jnp.float32)))
    idx = jnp.arange(CHUNK, dtype=jnp.float32)
    rel = idx[:, None] - idx[None, :]
    decay_mask = jnp.where(rel[None] >= 0, jnp.exp(jnp.maximum(rel, 0.0)[None] * log_gamma[:, None, None]), 0.0)
    qc = q.reshape(B, n, CHUNK, RET_HEADS, RET_HEAD_QK)
    kc = k.reshape(B, n, CHUNK, RET_HEADS, RET_HEAD_QK)
    vc = v.reshape(B, n, CHUNK, RET_HEADS, RET_HEAD_V)
    scores = jnp.einsum('bnchd,bnshd->bnhcs', qc, kc) * decay_mask.astype(dt)
    intra = jnp.einsum('bnhcs,bnshe->bnche', scores, vc)
    q_decay = jnp.exp((idx[:, None] + 1.0) * log_gamma[None, :])
    k_decay = jnp.exp((CHUNK - 1.0 - idx)[:, None] * log_gamma[None, :])
    chunk_decay = jnp.exp(CHUNK * log_gamma)
    qd = qc * q_decay[:, :, None].astype(dt)
    kd = kc * k_decay[:, :, None].astype(dt)
    xs = (jnp.moveaxis(qd, 1, 0), jnp.moveaxis(kd, 1, 0), jnp.moveaxis(vc, 1, 0))

    def step(state, inp):
        qi, ki, vi = inp
        cross_i = jnp.einsum('bchd,bhde->bche', qi.astype(jnp.float32), state)
        state = state * chunk_decay[None, :, None, None] + jnp.einsum(
            'bchd,bche->bhde', ki.astype(jnp.float32), vi.astype(jnp.float32))
        return state, cross_i.astype(dt)

    state0 = jnp.zeros((B, RET_HEADS, RET_HEAD_QK, RET_HEAD_V), jnp.float32)
    _, cross = lax.scan(step, state0, xs)
    o = intra + jnp.moveaxis(cross, 0, 1)
    o = o.reshape(B, S, RET_HEADS, RET_HEAD_V)
    o = _rms(o.astype(jnp.float32)).astype(dt).reshape(B, S, RET_V_DIM)
    return (jax.nn.silu(g) * o) @ w_out


def conv_ffn(h, w_up, conv_w, conv_b, w_down):
    S = h.shape[1]
    z = h @ w_up
    zp = jnp.pad(z, ((0, 0), (CONV_WIDTH - 1, 0), (0, 0)))
    zc = conv_b.astype(z.dtype)
    for tap in range(CONV_WIDTH):
        zc = zc + conv_w[tap].astype(z.dtype) * zp[:, tap:tap + S]
    gate, up = jnp.split(zc, 2, axis=-1)
    return (jax.nn.silu(gate) * up) @ w_down


def setup_inputs(seed: int = 0) -> dict:
    key = jax.random.key(seed)
    ks = jax.random.split(key, 20)
    f32 = jnp.float32

    def nrm(k, shape, scale):
        return jax.random.normal(k, shape, f32) * scale

    def gain(k, shape):
        return 1.0 + 0.02 * jax.random.normal(k, shape, f32)

    x = jax.random.normal(ks[0], (BATCH, SEQ, D_MODEL), f32)
    positions = jnp.broadcast_to(jnp.arange(SEQ, dtype=jnp.int32), (BATCH, SEQ))
    return {
        "x": x,
        "positions": positions,
        "mix_pre_g": gain(ks[1], (DEPTH, D_MODEL)),
        "mix_post_g": gain(ks[2], (DEPTH, D_MODEL)),
        "gmlp_w_in": nrm(ks[3], (N_LAYERS_A, D_MODEL, GMLP_DFF), D_MODEL ** -0.5),
        "gmlp_ln_g": gain(ks[4], (N_LAYERS_A, GMLP_HALF)),
        "gmlp_ln_b": nrm(ks[5], (N_LAYERS_A, GMLP_HALF), 0.02),
        "gmlp_w_s": nrm(ks[6], (N_LAYERS_A, GMLP_GROUPS, CHUNK, CHUNK), CHUNK ** -0.5),
        "gmlp_b_s": 1.0 + nrm(ks[7], (N_LAYERS_A, GMLP_GROUPS, CHUNK), 0.1),
        "gmlp_w_out": nrm(ks[8], (N_LAYERS_A, GMLP_HALF, D_MODEL), GMLP_HALF ** -0.5),
        "ret_w_in": nrm(ks[9], (N_LAYERS_B, D_MODEL, 2 * RET_QK_DIM + 2 * RET_V_DIM), D_MODEL ** -0.5),
        "ret_w_out": nrm(ks[10], (N_LAYERS_B, RET_V_DIM, D_MODEL), RET_V_DIM ** -0.5),
        "ffn_pre_g": gain(ks[11], (DEPTH, D_MODEL)),
        "ffn_post_g": gain(ks[12], (DEPTH, D_MODEL)),
        "ffn_w_up": nrm(ks[13], (DEPTH, D_MODEL, 2 * FFN_DIM), D_MODEL ** -0.5),
        "ffn_conv_w": nrm(ks[14], (DEPTH, CONV_WIDTH, 2 * FFN_DIM), CONV_WIDTH ** -0.5),
        "ffn_conv_b": nrm(ks[15], (DEPTH, 2 * FFN_DIM), 0.02),
        "ffn_w_down": nrm(ks[16], (DEPTH, FFN_DIM, D_MODEL), FFN_DIM ** -0.5),
    }


def reference(x, positions, mix_pre_g, mix_post_g, gmlp_w_in, gmlp_ln_g, gmlp_ln_b, gmlp_w_s,
              gmlp_b_s, gmlp_w_out, ret_w_in, ret_w_out, ffn_pre_g, ffn_post_g, ffn_w_up,
              ffn_conv_w, ffn_conv_b, ffn_w_down):
    for i in range(DEPTH):
        j = i // N_MIXERS
        hn = rmsnorm(x, mix_pre_g[i])
        if i % N_MIXERS == 0:
            y = gmlp_mixer(hn, gmlp_w_in[j], gmlp_ln_g[j], gmlp_ln_b[j], gmlp_w_s[j],
                           gmlp_b_s[j], gmlp_w_out[j])
        else:
            y = retention_mixer(hn, positions, ret_w_in[j], ret_w_out[j])
        x = x + rmsnorm(y, mix_post_g[i])
        hn = rmsnorm(x, ffn_pre_g[i])
        y = conv_ffn(hn, ffn_w_up[i], ffn_conv_w[i], ffn_conv_b[i], ffn_w_down[i])
        x = x + rmsnorm(y, ffn_post_g[i])
    return x
```

```cpp
#include <hip/hip_runtime.h>
#include <cstdio>
#include <cstdint>
namespace pg8 {
#define PG8_LAS __attribute__((address_space(3)))
typedef unsigned short bf16_t;
typedef short bf16x8 __attribute__((ext_vector_type(8)));
typedef float f32x4 __attribute__((ext_vector_type(4)));
typedef unsigned u32x4 __attribute__((ext_vector_type(4)));
constexpr int BM = 256, BK = 64, HALF = 128, HTB = HALF * BK * 2  , STAGE_BYTES = 8 * HTB, NXCD = 8, WGM = 8;

__host__ __device__ __forceinline__ int lds_byte(int r, int c) { const int st = (r >> 4) * 2 + (c >> 5), rr = r & 15, cc = c & 31, ob = rr * 64 + cc * 2; return st * 1024 + (ob ^ (((ob >> 9) & 1) << 5)); }
__host__ __device__ __forceinline__ void stage_rc(int b, int& R, int& C) { const int st = b / 1024, sb = b % 1024, swz = sb ^ (((sb >> 9) & 1) << 5); R = (st >> 1) * 16 + swz / 64; C = (st & 1) * 32 + (swz % 64) / 2; }
__host__ __device__ __forceinline__ int perm32(int rho) { const int n = rho >> 4, i = rho & 15; return 8 * (i >> 2) + 4 * n + (i & 3); }

struct Unit { int pm, pn; };
struct Gemm { const bf16_t* A; const bf16_t* Bt; int M, N, K; };

struct StaticOrder {
    int nM, nN, nwg, G, c;
    __host__ __device__ void init(int M, int N, int G_, int c_) { nM = M / BM; nN = N / BM; nwg = nM * nN; G = G_; c = c_; }
    __host__ __device__ bool next(int i, Unit& u) const {
        const long L = (long)i * G + c; if (L >= nwg) return false;
        int wgid = (int)L; { const int q = nwg / NXCD, r = nwg % NXCD, xcd = wgid % NXCD, off = wgid / NXCD; wgid = (xcd < r ? xcd * (q + 1) : r * (q + 1) + (xcd - r) * q) + off; }
        const int nig = WGM * nN, gid = wgid / nig, fm = gid * WGM, gsz = (nM - fm) < WGM ? (nM - fm) : WGM;
        u.pm = fm + ((wgid % nig) % gsz); u.pn = (wgid % nig) / gsz; return true;
    }
    __device__ __forceinline__ void a_ready(const Unit&) const {}
    __device__ __forceinline__ void done(const Unit&) const {}
};

__device__ __forceinline__ unsigned cvt_pk_bf16(float lo, float hi) { unsigned r; asm volatile("v_cvt_pk_bf16_f32 %0, %1, %2" : "=v"(r) : "v"(lo), "v"(hi)); return r; }
typedef float f32x2 __attribute__((ext_vector_type(2)));
__device__ __forceinline__ f32x2 gelu_pk(f32x2 v) {
    const f32x2 av = __builtin_elementwise_abs(v), d = av * 0.2316418882f + 1.0f;
    f32x2 t; t.x = __builtin_amdgcn_rcpf(d.x); t.y = __builtin_amdgcn_rcpf(d.y);
    f32x2 q = t * 0.5307027145f + (-0.7265760135f); q = q * t + 0.7107068705f; q = q * t + (-0.142248368f); q = q * t + 0.127414796f; q = q * t;
    const f32x2 s = (v * v) * (-0.72134752044f);
    f32x2 e; e.x = __builtin_amdgcn_exp2f(s.x); e.y = __builtin_amdgcn_exp2f(s.y);
    const f32x2 m = v * (q * e), r = v - m;
    f32x2 o; o.x = v.x < 0.f ? m.x : r.x; o.y = v.y < 0.f ? m.y : r.y; return o;
}

template <int ACT  > struct EpiBf16 {
    static constexpr bool PERM = true, AFTER_DRAIN = false; static_assert(ACT == 0 || ACT == 1, "EpiBf16: ACT is 0 (none) or 1 (gelu_pk)");
    bf16_t* O; int ldc; const float* bias; int split_cols; size_t split_stride; float scale0;
    __device__ __forceinline__ void operator()(const f32x4 (&acc)[2][2][4][2], const Unit& u, int wr, int wc, int fr, int fq) const {
        const int row0 = u.pm * BM + wr * 64 + fr; int colt = u.pn * BM; bf16_t* base = O;
        float sc = 1.f; if (split_cols) { const int t = colt / split_cols; base += (size_t)t * split_stride; colt -= t * split_cols; if (t == 0) sc = scale0; }
        const int col0 = colt + wc * 32 + 8 * fq, bcol0 = u.pn * BM + wc * 32 + 8 * fq;
        f32x4 bv[2][2];
#pragma unroll
        for (int bj = 0; bj < 2; ++bj)
#pragma unroll
            for (int n = 0; n < 2; ++n) bv[bj][n] = bias ? *(const f32x4*)(bias + bcol0 + bj * HALF + 4 * n) : (f32x4){0.f, 0.f, 0.f, 0.f};
#pragma unroll
        for (int ai = 0; ai < 2; ++ai)
#pragma unroll
            for (int m = 0; m < 4; ++m) { bf16_t* rowp = base + (size_t)(row0 + ai * HALF + m * 16) * ldc + col0;
#pragma unroll
                for (int bj = 0; bj < 2; ++bj) { f32x4 v0 = acc[ai][bj][m][0] + bv[bj][0], v1 = acc[ai][bj][m][1] + bv[bj][1];
                    if (ACT == 1) { f32x2 a = gelu_pk((f32x2){v0[0], v0[1]}), b = gelu_pk((f32x2){v0[2], v0[3]}), c = gelu_pk((f32x2){v1[0], v1[1]}), d = gelu_pk((f32x2){v1[2], v1[3]});
                        v0 = (f32x4){a.x, a.y, b.x, b.y}; v1 = (f32x4){c.x, c.y, d.x, d.y}; }
                    v0 = v0 * sc; v1 = v1 * sc; u32x4 w; w.x = cvt_pk_bf16(v0[0], v0[1]); w.y = cvt_pk_bf16(v0[2], v0[3]); w.z = cvt_pk_bf16(v1[0], v1[1]); w.w = cvt_pk_bf16(v1[2], v1[3]);
                    *(u32x4*)(rowp + bj * HALF) = w; } }
    }
};
template <class Epi, class Sched, bool ALIGN_EPI = false, bool SP2 = false>
__device__ __forceinline__ void gemm_phase(PG8_LAS unsigned char* lds, const Gemm g, const Sched& S, const Epi& E) {
    const int tid = threadIdx.x, wid = __builtin_amdgcn_readfirstlane(tid >> 6), lane = tid & 63, wr = wid >> 2, wc = wid & 3, fr = lane & 15, fq = lane >> 4;
    const int K = g.K, nt = K / BK;
    unsigned voffA[2], voffB[2];
#pragma unroll
    for (int i = 0; i < 2; ++i) { int R, C; stage_rc(tid * 16 + i * 8192, R, C); const int Rb = Epi::PERM ? ((R & ~31) + perm32(R & 31)) : R;
        voffA[i] = (unsigned)(R * K + C) * 2u; voffB[i] = (unsigned)(Rb * K + C) * 2u; }
    const size_t kstep = (size_t)(BK * 2);
    const size_t hstep = (size_t)HALF * K * 2;
    const size_t tstep = 2 * hstep;
    const unsigned ldsw = (unsigned)wid * 1024u;
    const int aoff = lds_byte(wr * 64 + fr, fq * 8), boff = lds_byte(wc * 32 + fr, fq * 8);
#define PG8_SA(b, h) (((b) * 2 + (h)) * HTB)
#define PG8_SB(b, h) ((4 + (b) * 2 + (h)) * HTB)
#define PG8_STAGE(bufoff, gbase, voff) do { _Pragma("unroll") for (int _i = 0; _i < 2; ++_i) \
        __builtin_amdgcn_global_load_lds((const unsigned*)((const char*)(gbase) + (voff)[_i]), (PG8_LAS unsigned*)(lds + (bufoff) + ldsw + _i * 8192), 16, 0, 0); } while (0)
#define PG8_LDA(dst, b, h) do { _Pragma("unroll") for (int m = 0; m < 4; ++m) _Pragma("unroll") for (int k = 0; k < 2; ++k) dst[m][k] = *(const PG8_LAS bf16x8*)(lds + PG8_SA(b, h) + aoff + m * 2048 + k * 1024); } while (0)
#define PG8_LDB(dst, b, h) do { _Pragma("unroll") for (int n = 0; n < 2; ++n) _Pragma("unroll") for (int k = 0; k < 2; ++k) dst[n][k] = *(const PG8_LAS bf16x8*)(lds + PG8_SB(b, h) + boff + n * 2048 + k * 1024); } while (0)
#define PG8_MMA(ai, bj, At, Bt) do { __builtin_amdgcn_s_setprio(1); _Pragma("unroll") for (int m = 0; m < 4; ++m) _Pragma("unroll") for (int n = 0; n < 2; ++n) _Pragma("unroll") for (int k = 0; k < 2; ++k) \
        acc[ai][bj][m][n] = __builtin_amdgcn_mfma_f32_16x16x32_bf16(Bt[n][k], At[m][k], acc[ai][bj][m][n], 0, 0, 0); __builtin_amdgcn_s_setprio(0); } while (0)
#define PG8_WAIT_V(n) asm volatile("s_waitcnt vmcnt(" #n ")" ::: "memory")
#define PG8_WAIT_L(n) asm volatile("s_waitcnt lgkmcnt(" #n ")" ::: "memory")
#define PG8_BAR __builtin_amdgcn_s_barrier()
#define PG8_SCHED __builtin_amdgcn_sched_barrier(0)
    Unit cur, nxt; int ui = 0;
    if (!S.next(0, cur)) return;
    f32x4 acc[2][2][4][2];
#pragma unroll
    for (int a = 0; a < 2; ++a)
#pragma unroll
        for (int b = 0; b < 2; ++b)
#pragma unroll
            for (int m = 0; m < 4; ++m)
#pragma unroll
                for (int n = 0; n < 2; ++n) acc[a][b][m][n] = (f32x4){0.f, 0.f, 0.f, 0.f};
    bf16x8 At[4][2], B0[2][2], B1[2][2];
    const char* cA = (const char*)g.A + (size_t)cur.pm * tstep; const char* cB = (const char*)g.Bt + (size_t)cur.pn * tstep;
    S.a_ready(cur);
    if constexpr (SP2) {
        PG8_STAGE(PG8_SB(0, 0), cB, voffB); PG8_STAGE(PG8_SB(0, 1), cB + hstep, voffB); PG8_STAGE(PG8_SA(0, 0), cA, voffA); PG8_STAGE(PG8_SA(0, 1), cA + hstep, voffA);
        if (wr == 1) PG8_BAR;
        PG8_WAIT_V(2); PG8_BAR;
        PG8_STAGE(PG8_SB(1, 0), cB + kstep, voffB); PG8_STAGE(PG8_SA(1, 0), cA + kstep, voffA); PG8_STAGE(PG8_SB(1, 1), cB + hstep + kstep, voffB);
        PG8_WAIT_V(6); PG8_BAR;
    } else {
        PG8_STAGE(PG8_SB(0, 0), cB, voffB); PG8_STAGE(PG8_SA(0, 0), cA, voffA); PG8_STAGE(PG8_SB(0, 1), cB + hstep, voffB); PG8_STAGE(PG8_SA(0, 1), cA + hstep, voffA);
        if (wr == 1) PG8_BAR;
        PG8_WAIT_V(4); PG8_BAR;
        PG8_STAGE(PG8_SB(1, 0), cB + kstep, voffB); PG8_STAGE(PG8_SA(1, 0), cA + kstep, voffA); PG8_STAGE(PG8_SB(1, 1), cB + hstep + kstep, voffB);
        PG8_WAIT_V(6); PG8_BAR;
    }
    for (;;) {
        const bool has_next = S.next(ui + 1, nxt);
        const char* nA = has_next ? (const char*)g.A + (size_t)nxt.pm * tstep : cA; const char* nB = has_next ? (const char*)g.Bt + (size_t)nxt.pn * tstep : cB;
        for (int t = 0; t < nt; t += 2) {
            const bool last = (t == nt - 2);
            const char* a1 = cA + (size_t)(t + 1) * kstep;
            const char* a2 = last ? nA : cA + (size_t)(t + 2) * kstep; const char* b2 = last ? nB : cB + (size_t)(t + 2) * kstep;
            const char* a3 = a2 + kstep; const char* b3 = b2 + kstep;
            if (last && has_next) S.a_ready(nxt);
            if constexpr (SP2) {
            PG8_LDB(B0, 0, 0); PG8_LDB(B1, 0, 1); PG8_SCHED; PG8_LDA(At, 0, 0); PG8_STAGE(PG8_SA(1, 1), a1 + hstep, voffA);
            PG8_WAIT_V(8); PG8_WAIT_L(0); PG8_BAR; PG8_MMA(0, 0, At, B0); PG8_MMA(0, 1, At, B1); PG8_BAR; PG8_SCHED;
            PG8_LDA(At, 0, 1); PG8_STAGE(PG8_SB(0, 0), b2, voffB); PG8_STAGE(PG8_SB(0, 1), b2 + hstep, voffB); PG8_STAGE(PG8_SA(0, 0), a2, voffA);
            PG8_WAIT_V(8); PG8_WAIT_L(0); PG8_BAR; PG8_MMA(1, 0, At, B0); PG8_MMA(1, 1, At, B1); PG8_BAR; PG8_SCHED;
            PG8_LDB(B0, 1, 0); PG8_LDB(B1, 1, 1); PG8_SCHED; PG8_LDA(At, 1, 0); PG8_STAGE(PG8_SA(0, 1), a2 + hstep, voffA);
            PG8_WAIT_V(8); PG8_WAIT_L(0); PG8_BAR; PG8_MMA(0, 0, At, B0); PG8_MMA(0, 1, At, B1); PG8_BAR; PG8_SCHED;
            PG8_LDA(At, 1, 1); PG8_STAGE(PG8_SB(1, 0), b3, voffB); PG8_STAGE(PG8_SB(1, 1), b3 + hstep, voffB); PG8_STAGE(PG8_SA(1, 0), a3, voffA);
            PG8_WAIT_V(8); PG8_WAIT_L(0); PG8_BAR; PG8_MMA(1, 0, At, B0); PG8_MMA(1, 1, At, B1); PG8_BAR; PG8_SCHED;
            } else {
            PG8_LDB(B0, 0, 0); PG8_SCHED; PG8_LDA(At, 0, 0); PG8_STAGE(PG8_SA(1, 1), a1 + hstep, voffA);
            PG8_WAIT_L(8); PG8_BAR; PG8_WAIT_L(0); PG8_MMA(0, 0, At, B0); PG8_BAR; PG8_SCHED;
            PG8_LDB(B1, 0, 1); PG8_STAGE(PG8_SB(0, 0), b2, voffB);
            PG8_BAR; PG8_WAIT_L(0); PG8_MMA(0, 1, At, B1); PG8_BAR;
            PG8_LDA(At, 0, 1); PG8_STAGE(PG8_SA(0, 0), a2, voffA);
            PG8_BAR; PG8_WAIT_L(0); PG8_MMA(1, 0, At, B0); PG8_BAR; PG8_SCHED;
            PG8_STAGE(PG8_SB(0, 1), b2 + hstep, voffB);
            PG8_WAIT_V(6); PG8_BAR; PG8_MMA(1, 1, At, B1); PG8_BAR;
            PG8_LDB(B0, 1, 0); PG8_SCHED; PG8_LDA(At, 1, 0); PG8_STAGE(PG8_SA(0, 1), a2 + hstep, voffA);
            PG8_WAIT_L(8); PG8_BAR; PG8_WAIT_L(0); PG8_MMA(0, 0, At, B0); PG8_BAR; PG8_SCHED;
            PG8_LDB(B1, 1, 1); PG8_STAGE(PG8_SB(1, 0), b3, voffB);
            PG8_BAR; PG8_WAIT_L(0); PG8_MMA(0, 1, At, B1); PG8_BAR;
            PG8_LDA(At, 1, 1); PG8_STAGE(PG8_SA(1, 0), a3, voffA);
            PG8_BAR; PG8_WAIT_L(0); PG8_MMA(1, 0, At, B0); PG8_BAR; PG8_SCHED;
            PG8_STAGE(PG8_SB(1, 1), b3 + hstep, voffB);
            PG8_WAIT_V(6); PG8_BAR; PG8_MMA(1, 1, At, B1); PG8_BAR;
            }
        }
        if constexpr (ALIGN_EPI) { if (wr == 0) PG8_BAR; }
        if constexpr (!Epi::AFTER_DRAIN) { E(acc, cur, wr, wc, fr, fq); S.done(cur); }
        if (!has_next) break;
#pragma unroll
        for (int a = 0; a < 2; ++a)
#pragma unroll
            for (int b = 0; b < 2; ++b)
#pragma unroll
                for (int m = 0; m < 4; ++m)
#pragma unroll
                    for (int n = 0; n < 2; ++n) acc[a][b][m][n] = (f32x4){0.f, 0.f, 0.f, 0.f};
        cur = nxt; cA = nA; cB = nB; ++ui;
        if constexpr (ALIGN_EPI) { if (wr == 1) PG8_BAR; }
    }
    PG8_WAIT_V(0);
    if constexpr (!ALIGN_EPI) { if (wr == 0) PG8_BAR; }
    PG8_BAR;
    if constexpr (Epi::AFTER_DRAIN) { E.fused(acc, cur, wr, wc, fr, fq, lds, wid, lane); S.done(cur); }
#undef PG8_SA
#undef PG8_SB
#undef PG8_STAGE
#undef PG8_LDA
#undef PG8_LDB
#undef PG8_MMA
#undef PG8_WAIT_V
#undef PG8_WAIT_L
#undef PG8_BAR
#undef PG8_SCHED
}
}
namespace pg8 {
typedef float f32x2e __attribute__((ext_vector_type(2))); typedef __bf16 bf16x2e __attribute__((ext_vector_type(2)));
__device__ __forceinline__ unsigned pk_bf16(float lo, float hi) { f32x2e v = {lo, hi}; bf16x2e b = __builtin_convertvector(v, bf16x2e); return __builtin_bit_cast(unsigned, b); }
struct EpiPlain {
    static constexpr bool PERM = true, AFTER_DRAIN = false;
    bf16_t* O; int ldc;
    __device__ __forceinline__ void operator()(const f32x4 (&acc)[2][2][4][2], const Unit& u, int wr, int wc, int fr, int fq) const {
        const int row0 = u.pm * BM + wr * 64 + fr, col0 = u.pn * BM + wc * 32 + 8 * fq;
#pragma unroll
        for (int ai = 0; ai < 2; ++ai)
#pragma unroll
            for (int m = 0; m < 4; ++m) { bf16_t* rowp = O + (size_t)(row0 + ai * HALF + m * 16) * ldc + col0;
#pragma unroll
                for (int bj = 0; bj < 2; ++bj) { const f32x4 v0 = acc[ai][bj][m][0], v1 = acc[ai][bj][m][1];
                    u32x4 w; w.x = pk_bf16(v0[0], v0[1]); w.y = pk_bf16(v0[2], v0[3]); w.z = pk_bf16(v1[0], v1[1]); w.w = pk_bf16(v1[2], v1[3]);
                    *(u32x4*)(rowp + bj * HALF) = w; } }
    }
};
struct EpiGeluSplit {
    static constexpr bool PERM = true, AFTER_DRAIN = false;
    bf16_t* O; int ldc; int split_cols; size_t split_stride;
    __device__ __forceinline__ void operator()(const f32x4 (&acc)[2][2][4][2], const Unit& u, int wr, int wc, int fr, int fq) const {
        const int row0 = u.pm * BM + wr * 64 + fr; int colt = u.pn * BM; bf16_t* base = O;
        const int t = colt / split_cols; base += (size_t)t * split_stride; colt -= t * split_cols;
        const int col0 = colt + wc * 32 + 8 * fq;
#pragma unroll
        for (int ai = 0; ai < 2; ++ai)
#pragma unroll
            for (int m = 0; m < 4; ++m) { const int row = row0 + ai * HALF + m * 16; bf16_t* rowp = base + (size_t)row * ldc + col0;
#pragma unroll
                for (int bj = 0; bj < 2; ++bj) { f32x4 v0 = acc[ai][bj][m][0], v1 = acc[ai][bj][m][1];
                    { f32x2 a = gelu_pk((f32x2){v0[0], v0[1]}), b = gelu_pk((f32x2){v0[2], v0[3]}), c = gelu_pk((f32x2){v1[0], v1[1]}), d = gelu_pk((f32x2){v1[2], v1[3]});
                      v0 = (f32x4){a.x, a.y, b.x, b.y}; v1 = (f32x4){c.x, c.y, d.x, d.y}; }
                    u32x4 w; w.x = pk_bf16(v0[0], v0[1]); w.y = pk_bf16(v0[2], v0[3]); w.z = pk_bf16(v1[0], v1[1]); w.w = pk_bf16(v1[2], v1[3]);
                    *(u32x4*)(rowp + bj * HALF) = w; } }
    }
};
struct EpiRetIn {
    static constexpr bool PERM = true, AFTER_DRAIN = false;
    bf16_t* O; int ldc; const int* pos;
    __device__ __forceinline__ void operator()(const f32x4 (&acc)[2][2][4][2], const Unit& u, int wr, int wc, int fr, int fq) const {
        const int row0 = u.pm * BM + wr * 64 + fr, col0 = u.pn * BM + wc * 32 + 8 * fq;
        const bool rope = u.pn < 16; const float ksc = (u.pn >= 8) ? 0.0625f : 1.0f;
        float fr_[2][4];
#pragma unroll
        for (int bj = 0; bj < 2; ++bj)
#pragma unroll
            for (int p = 0; p < 4; ++p) { const int i = 64 * bj + 16 * wc + 4 * fq + p; fr_[bj][p] = __builtin_amdgcn_exp2f(-(float)i * (13.287712379549449f / 127.0f)) * 0.15915494309189535f; }
#pragma unroll
        for (int ai = 0; ai < 2; ++ai)
#pragma unroll
            for (int m = 0; m < 4; ++m) { const int row = row0 + ai * HALF + m * 16; bf16_t* rowp = O + (size_t)row * ldc + col0; const float pp = rope ? (float)pos[row] : 0.f;
#pragma unroll
                for (int bj = 0; bj < 2; ++bj) { f32x4 v0 = acc[ai][bj][m][0], v1 = acc[ai][bj][m][1];
                    if (rope) {
                        float x[8] = {v0[0], v0[1], v0[2], v0[3], v1[0], v1[1], v1[2], v1[3]};
#pragma unroll
                        for (int p = 0; p < 4; ++p) { float rev = pp * fr_[bj][p]; rev = __builtin_amdgcn_fractf(rev); const float sn = __builtin_amdgcn_sinf(rev), cs = __builtin_amdgcn_cosf(rev);
                            const float a = x[2 * p], b = x[2 * p + 1]; x[2 * p] = (a * cs - b * sn) * ksc; x[2 * p + 1] = (b * cs + a * sn) * ksc; }
                        v0 = (f32x4){x[0], x[1], x[2], x[3]}; v1 = (f32x4){x[4], x[5], x[6], x[7]}; }
                    u32x4 w; w.x = pk_bf16(v0[0], v0[1]); w.y = pk_bf16(v0[2], v0[3]); w.z = pk_bf16(v1[0], v1[1]); w.w = pk_bf16(v1[2], v1[3]);
                    *(u32x4*)(rowp + bj * HALF) = w; } }
    }
};
}
constexpr int NWAVES = 8;
constexpr int NB = 4, SEQ = 4096, M = NB * SEQ, D = 2048;
constexpr int GH = 6144, GD = 2 * GH;
constexpr int RPROJ = 12288, RV = 4096;
constexpr int FF = 5632, FF2 = 2 * FF;
constexpr float EPS = 1e-6f;
constexpr size_t MiB = 1u << 20;
constexpr size_t WS_CTL = 0, WS_STATS = 1 * MiB, ZERO_BYTES = 2 * MiB;
constexpr size_t WS_WA = 2 * MiB;
constexpr size_t WS_WB = 50 * MiB;
constexpr size_t WS_HN = 74 * MiB;
constexpr size_t WS_BIG = 138 * MiB;
constexpr size_t WS_H2 = 522 * MiB;
constexpr size_t WS_END = 698 * MiB;
constexpr size_t ST_S1 = 0, ST_S2 = (size_t)M * 4, ST_SS = (size_t)M * 8;
static_assert(ST_SS + (size_t)8 * M * 4 <= MiB, "stats region");
constexpr int CW_TMO = 0, CW_CODE = 1, CW_BAR = 4096, CW_DBG = 16384;
constexpr int RING_BYTES = 131072, LDSCTL_OFF = RING_BYTES, MISC_OFF = LDSCTL_OFF + 320, LDS_BYTES = 147456;
#define GAS __attribute__((address_space(1)))
#define LAS __attribute__((address_space(3)))
typedef unsigned short bf16;
typedef unsigned v4u __attribute__((ext_vector_type(4)));
typedef float f32x4 __attribute__((ext_vector_type(4)));
typedef short bf16x8 __attribute__((ext_vector_type(8)));
typedef GAS unsigned gu32;
typedef GAS unsigned long long gu64;
#define RLX_AGENT __ATOMIC_RELAXED, __HIP_MEMORY_SCOPE_AGENT
#define LDS_WAIT() asm volatile("s_waitcnt lgkmcnt(0)" ::: "memory")
#define VM_WAIT() asm volatile("s_waitcnt vmcnt(0)" ::: "memory")
__device__ __forceinline__ unsigned long long rt() { return __builtin_amdgcn_s_memrealtime(); }
__device__ __forceinline__ unsigned f2bf(float f) { unsigned u = __builtin_bit_cast(unsigned, f); return (u + 0x7fffu + ((u >> 16) & 1u)) >> 16; }
__device__ __forceinline__ unsigned pk2(float lo, float hi) { return f2bf(lo) | (f2bf(hi) << 16); }

#define XB_TMO      128
#define XB_XCNT(j)  (256  + 64 * (j))
#define XB_XSUB(j)  (1280 + 64 * (j))
#define XB_XGEN(j)  (2304 + 64 * (j))
#define XB_TOP      3328
#define XB_TOPGEN   3392
#define XCD_BAR_WORDS 3456
#define XB_SPIN_CAP (1u << 18)

__device__ __forceinline__ unsigned xb_ld(unsigned* p)              { return __hip_atomic_load(p, __ATOMIC_RELAXED, __HIP_MEMORY_SCOPE_AGENT); }
__device__ __forceinline__ unsigned xb_add(unsigned* p, unsigned v) { return __hip_atomic_fetch_add(p, v, __ATOMIC_RELAXED, __HIP_MEMORY_SCOPE_AGENT); }
__device__ __forceinline__ unsigned xb_xcc_id() { return (unsigned)__builtin_amdgcn_s_getreg((3 << 11) | 20) & 0xFu; }
#define XB_SPIN(cond, bar) do { unsigned _sp = 0; while (cond) { __builtin_amdgcn_s_sleep(1); \
    if ((++_sp & 255u) == 0u) { if (xb_ld(&(bar)[XB_TMO])) break; if (_sp > XB_SPIN_CAP) { atomicAdd(&(bar)[XB_TMO], 1u); break; } } } } while (0)

struct XcdBarrier {
    unsigned* bar; unsigned x;
    volatile LAS unsigned* st;
};

__device__ __forceinline__ XcdBarrier xcd_barrier_post(unsigned* bar, volatile LAS unsigned* st) {
    XcdBarrier b; b.bar = bar; b.x = xb_xcc_id(); b.st = st;
    if (threadIdx.x == 0) (void)xb_add(&bar[XB_XCNT(b.x)], 1u);
    return b;
}
__device__ __forceinline__ void xcd_barrier_complete(unsigned* bar, unsigned x, unsigned& nloc, unsigned& nx) {
    const unsigned G = gridDim.x * gridDim.y * gridDim.z;
    unsigned sum, cnt, mine, sp = 0u;
    for (;;) {
        sum = 0u; cnt = 0u; mine = 0u;
#pragma unroll
        for (unsigned j = 0; j < 16; ++j) { const unsigned c = xb_ld(&bar[XB_XCNT(j)]); sum += c; cnt += (c > 0u) ? 1u : 0u; mine = (j == x) ? c : mine; }
        if (sum == G) break;
        __builtin_amdgcn_s_sleep(1);
        if ((++sp & 255u) == 0u) { if (xb_ld(&bar[XB_TMO])) break; if (sp > XB_SPIN_CAP) { atomicAdd(&bar[XB_TMO], 1u); break; } }
    }
    nloc = mine > 0u ? mine : 1u; nx = cnt > 0u ? cnt : 1u;
}

__device__ __forceinline__ void xcd_barrier(const XcdBarrier& b) {
    asm volatile("s_waitcnt vmcnt(0)" ::: "memory");
    __syncthreads();
    if (threadIdx.x == 0) {
        unsigned* bar = b.bar;
        __builtin_amdgcn_s_waitcnt(0);
        unsigned nloc = b.st[0], nx = b.st[1];
        if (nloc == 0u) { xcd_barrier_complete(bar, b.x, nloc, nx); b.st[0] = nloc; b.st[1] = nx; }
        const unsigned old = xb_add(&bar[XB_XSUB(b.x)], 1u);
        const unsigned gen = old / nloc;
        if (old + 1u == (gen + 1u) * nloc) {
            __builtin_amdgcn_fence(__ATOMIC_RELEASE, "agent");
            asm volatile("s_waitcnt vmcnt(0)" ::: "memory");
            const unsigned og = xb_add(&bar[XB_TOP], 1u);
            const unsigned tg = og / nx;
            if (og + 1u == (tg + 1u) * nx) xb_add(&bar[XB_TOPGEN], 1u);
            else XB_SPIN(xb_ld(&bar[XB_TOPGEN]) == tg, bar);
            __builtin_amdgcn_fence(__ATOMIC_ACQUIRE, "agent");
            xb_add(&bar[XB_XGEN(b.x)], 1u);
            asm volatile("s_waitcnt vmcnt(0)" ::: "memory");
        } else {
            XB_SPIN(xb_ld(&bar[XB_XGEN(b.x)]) == gen, bar);
            __builtin_amdgcn_fence(__ATOMIC_ACQUIRE, "agent");
            asm volatile("s_waitcnt vmcnt(0)" ::: "memory");
        }
    }
    __syncthreads();
}
template <int CTRL> __device__ __forceinline__ float dppf(float v) { return __builtin_bit_cast(float, __builtin_amdgcn_mov_dpp(__builtin_bit_cast(int, v), CTRL, 0xF, 0xF, true)); }
__device__ __forceinline__ float wave_sum(float v) {
    v += dppf<0xB1>(v); v += dppf<0x4E>(v); v += dppf<0x141>(v); v += dppf<0x140>(v);
    v += __builtin_bit_cast(float, __builtin_amdgcn_ds_swizzle(__builtin_bit_cast(int, v), 0x401F));
    return __builtin_bit_cast(float, __builtin_amdgcn_readlane(__builtin_bit_cast(int, v), 0)) + __builtin_bit_cast(float, __builtin_amdgcn_readlane(__builtin_bit_cast(int, v), 32));
}
__device__ __forceinline__ void p0_transpose_item(const float* W, int K, int N, bf16* WT, int row_off, LAS float* scr, int item, int lane) {
    const int nblk = N / 32, kb = item / nblk, nb = item % nblk, k0 = 64 * kb, n0 = 32 * nb;
#pragma unroll 8
    for (int i = 0; i < 32; ++i) { const int kk = 2 * i + (lane >> 5); scr[kk * 33 + (lane & 31)] = W[(size_t)(k0 + kk) * N + n0 + (lane & 31)]; }
    LDS_WAIT(); asm volatile("" ::: "memory");
    const int c = lane & 7;
#pragma unroll
    for (int j = 0; j < 4; ++j) { const int n = (lane >> 3) + 8 * j; const LAS float* s = scr + (8 * c) * 33 + n;
        v4u o; o.x = pk2(s[0 * 33], s[1 * 33]); o.y = pk2(s[2 * 33], s[3 * 33]); o.z = pk2(s[4 * 33], s[5 * 33]); o.w = pk2(s[6 * 33], s[7 * 33]);
        *(GAS v4u*)(WT + (size_t)(row_off + n0 + n) * K + k0 + 8 * c) = o; }
    LDS_WAIT(); asm volatile("" ::: "memory");
}
typedef float f32x16 __attribute__((ext_vector_type(16)));
typedef short s16x4 __attribute__((ext_vector_type(4)));
typedef unsigned v2u __attribute__((ext_vector_type(2)));
typedef float f32x2_t __attribute__((ext_vector_type(2))); typedef __bf16 bf16x2_t __attribute__((ext_vector_type(2)));
__device__ __forceinline__ unsigned pkbf(float lo, float hi) { f32x2_t v = {lo, hi}; bf16x2_t b = __builtin_convertvector(v, bf16x2_t); return __builtin_bit_cast(unsigned, b); }
__device__ __forceinline__ float bflo(unsigned w) { return __builtin_bit_cast(float, w << 16); }
__device__ __forceinline__ float bfhi(unsigned w) { return __builtin_bit_cast(float, w & 0xffff0000u); }
__device__ __forceinline__ void unpack8(const v4u& w, float (&f)[8]) { f[0] = bflo(w.x); f[1] = bfhi(w.x); f[2] = bflo(w.y); f[3] = bfhi(w.y); f[4] = bflo(w.z); f[5] = bfhi(w.z); f[6] = bflo(w.w); f[7] = bfhi(w.w); }
__device__ __forceinline__ v4u pack8(const float (&f)[8]) { v4u w; w.x = pkbf(f[0], f[1]); w.y = pkbf(f[2], f[3]); w.z = pkbf(f[4], f[5]); w.w = pkbf(f[6], f[7]); return w; }
__device__ __forceinline__ s16x4 tr_rd(LAS const unsigned char* p) { typedef short v4i16_t __attribute__((ext_vector_type(4))); return __builtin_bit_cast(s16x4, __builtin_amdgcn_ds_read_tr16_b64_v4i16((LAS v4i16_t*)p)); }
__device__ __forceinline__ bf16x8 cat8(s16x4 lo, s16x4 hi) { return __builtin_shufflevector(lo, hi, 0, 1, 2, 3, 4, 5, 6, 7); }
#define MFMA32(a, b, c) __builtin_amdgcn_mfma_f32_32x32x16_bf16((a), (b), (c), 0, 0, 0)
__device__ __forceinline__ f32x16 zero16() { f32x16 z;
#pragma unroll
    for (int i = 0; i < 16; ++i) z[i] = 0.f; return z; }
__device__ __forceinline__ float silu_f(float x) { return x * __builtin_amdgcn_rcpf(1.0f + __builtin_amdgcn_exp2f(-1.4426950408889634f * x)); }

__device__ __forceinline__ void convert_weight(const float* W, int K, int N, bf16* WT, LAS unsigned char* lds, int gw, int NGW, int wave, int lane) {
    LAS float* scr = (LAS float*)(lds + wave * 16384);
    const int nblk = N / 32, nitems = (K / 64) * nblk;
    for (int it = gw; it < nitems; it += NGW) p0_transpose_item(W, K, N, WT, 0, scr, it, lane);
}

__device__ __forceinline__ void first_norm_phase(int gw, int NGW, int lane, const float* x, const float* g, bf16* hn) {
    float gg[4][8];
#pragma unroll
    for (int j = 0; j < 4; ++j) { const f32x4 a = ((const GAS f32x4*)g)[2 * (lane + 64 * j)], b = ((const GAS f32x4*)g)[2 * (lane + 64 * j) + 1]; gg[j][0] = a.x; gg[j][1] = a.y; gg[j][2] = a.z; gg[j][3] = a.w; gg[j][4] = b.x; gg[j][5] = b.y; gg[j][6] = b.z; gg[j][7] = b.w; }
    for (int m = gw; m < M; m += NGW) {
        const GAS f32x4* xr = (const GAS f32x4*)(x + (size_t)m * D);
        float xv[4][8]; float ss = 0.f;
#pragma unroll
        for (int j = 0; j < 4; ++j) { const f32x4 a = xr[2 * (lane + 64 * j)], b = xr[2 * (lane + 64 * j) + 1]; xv[j][0] = a.x; xv[j][1] = a.y; xv[j][2] = a.z; xv[j][3] = a.w; xv[j][4] = b.x; xv[j][5] = b.y; xv[j][6] = b.z; xv[j][7] = b.w;
#pragma unroll
            for (int i = 0; i < 8; ++i) ss += xv[j][i] * xv[j][i]; }
        const float r = rsqrtf(wave_sum(ss) * (1.0f / D) + EPS);
        GAS v4u* o = (GAS v4u*)(hn + (size_t)m * D);
#pragma unroll
        for (int j = 0; j < 4; ++j) { float t[8];
#pragma unroll
            for (int i = 0; i < 8; ++i) t[i] = xv[j][i] * r * gg[j][i];
            o[lane + 64 * j] = pack8(t); }
    }
}
template <bool NEXT>
__device__ __forceinline__ void resid_norm_phase(int gw, int NGW, int lane, const bf16* Y, const float* xin, float* xout, const float* gpost, const float* gnext, bf16* hn) {
    float gp[4][8], gn[4][8];
#pragma unroll
    for (int j = 0; j < 4; ++j) { const f32x4 a = ((const GAS f32x4*)gpost)[2 * (lane + 64 * j)], b = ((const GAS f32x4*)gpost)[2 * (lane + 64 * j) + 1]; gp[j][0] = a.x; gp[j][1] = a.y; gp[j][2] = a.z; gp[j][3] = a.w; gp[j][4] = b.x; gp[j][5] = b.y; gp[j][6] = b.z; gp[j][7] = b.w;
        if (NEXT) { const f32x4 c = ((const GAS f32x4*)gnext)[2 * (lane + 64 * j)], d = ((const GAS f32x4*)gnext)[2 * (lane + 64 * j) + 1]; gn[j][0] = c.x; gn[j][1] = c.y; gn[j][2] = c.z; gn[j][3] = c.w; gn[j][4] = d.x; gn[j][5] = d.y; gn[j][6] = d.z; gn[j][7] = d.w; } }
    for (int m = gw; m < M; m += NGW) {
        const GAS v4u* yr = (const GAS v4u*)(Y + (size_t)m * D);
        const GAS f32x4* xr = (const GAS f32x4*)(xin + (size_t)m * D);
        GAS f32x4* xo = (GAS f32x4*)(xout + (size_t)m * D);
        float yv[4][8], xv[4][8]; float ss = 0.f;
#pragma unroll
        for (int j = 0; j < 4; ++j) { const v4u w = yr[lane + 64 * j]; unpack8(w, yv[j]);
            const f32x4 a = xr[2 * (lane + 64 * j)], b = xr[2 * (lane + 64 * j) + 1]; xv[j][0] = a.x; xv[j][1] = a.y; xv[j][2] = a.z; xv[j][3] = a.w; xv[j][4] = b.x; xv[j][5] = b.y; xv[j][6] = b.z; xv[j][7] = b.w;
#pragma unroll
            for (int i = 0; i < 8; ++i) ss += yv[j][i] * yv[j][i]; }
        const float r1 = rsqrtf(wave_sum(ss) * (1.0f / D) + EPS); float s2 = 0.f;
#pragma unroll
        for (int j = 0; j < 4; ++j) {
#pragma unroll
            for (int i = 0; i < 8; ++i) { xv[j][i] += yv[j][i] * r1 * gp[j][i]; s2 += xv[j][i] * xv[j][i]; }
            xo[2 * (lane + 64 * j)] = (f32x4){xv[j][0], xv[j][1], xv[j][2], xv[j][3]}; xo[2 * (lane + 64 * j) + 1] = (f32x4){xv[j][4], xv[j][5], xv[j][6], xv[j][7]}; }
        if (NEXT) { const float r2 = rsqrtf(wave_sum(s2) * (1.0f / D) + EPS); GAS v4u* o = (GAS v4u*)(hn + (size_t)m * D);
#pragma unroll
            for (int j = 0; j < 4; ++j) { float t[8];
#pragma unroll
                for (int i = 0; i < 8; ++i) t[i] = xv[j][i] * r2 * gn[j][i];
                o[lane + 64 * j] = pack8(t); } }
    }
}
__device__ __forceinline__ void conv_gate_phase(int gw, int NGW, int lane, const bf16* Z, bf16* H, const float* cw, const float* cb) {
    constexpr int RB = 32, NRB = M / RB, NCG = FF / 512;
    for (int it = gw; it < NRB * NCG; it += NGW) {
        const int rb = it / NCG, cg = it % NCG, c0 = 8 * (cg * 64 + lane), m0 = rb * RB;
        float wg[3][8], wu[3][8], bg[8], bu[8];
#pragma unroll
        for (int t = 0; t < 3; ++t) { const GAS f32x4* p = (const GAS f32x4*)(cw + (size_t)t * FF2 + c0); const GAS f32x4* q = (const GAS f32x4*)(cw + (size_t)t * FF2 + FF + c0);
            const f32x4 a = p[0], b = p[1], c = q[0], d = q[1]; wg[t][0] = a.x; wg[t][1] = a.y; wg[t][2] = a.z; wg[t][3] = a.w; wg[t][4] = b.x; wg[t][5] = b.y; wg[t][6] = b.z; wg[t][7] = b.w;
            wu[t][0] = c.x; wu[t][1] = c.y; wu[t][2] = c.z; wu[t][3] = c.w; wu[t][4] = d.x; wu[t][5] = d.y; wu[t][6] = d.z; wu[t][7] = d.w; }
        { const GAS f32x4* p = (const GAS f32x4*)(cb + c0); const GAS f32x4* q = (const GAS f32x4*)(cb + FF + c0); const f32x4 a = p[0], b = p[1], c = q[0], d = q[1];
          bg[0] = a.x; bg[1] = a.y; bg[2] = a.z; bg[3] = a.w; bg[4] = b.x; bg[5] = b.y; bg[6] = b.z; bg[7] = b.w; bu[0] = c.x; bu[1] = c.y; bu[2] = c.z; bu[3] = c.w; bu[4] = d.x; bu[5] = d.y; bu[6] = d.z; bu[7] = d.w; }
        float g1[8], g2[8], u1[8], u2[8];
        if ((m0 % SEQ) == 0) {
#pragma unroll
            for (int i = 0; i < 8; ++i) { g1[i] = 0.f; g2[i] = 0.f; u1[i] = 0.f; u2[i] = 0.f; }
        } else {
            const v4u a = *(const GAS v4u*)(Z + (size_t)(m0 - 1) * FF2 + c0), b = *(const GAS v4u*)(Z + (size_t)(m0 - 2) * FF2 + c0);
            const v4u c = *(const GAS v4u*)(Z + (size_t)(m0 - 1) * FF2 + FF + c0), d = *(const GAS v4u*)(Z + (size_t)(m0 - 2) * FF2 + FF + c0);
            unpack8(a, g1); unpack8(b, g2); unpack8(c, u1); unpack8(d, u2);
        }
#pragma unroll 4
        for (int r = 0; r < RB; ++r) { const int m = m0 + r;
            const v4u a = *(const GAS v4u*)(Z + (size_t)m * FF2 + c0), c = *(const GAS v4u*)(Z + (size_t)m * FF2 + FF + c0);
            float zg[8], zu[8], o[8]; unpack8(a, zg); unpack8(c, zu);
#pragma unroll
            for (int i = 0; i < 8; ++i) { const float gt = bg[i] + wg[0][i] * g2[i] + wg[1][i] * g1[i] + wg[2][i] * zg[i]; const float up = bu[i] + wu[0][i] * u2[i] + wu[1][i] * u1[i] + wu[2][i] * zu[i];
                o[i] = silu_f(gt) * up; g2[i] = g1[i]; g1[i] = zg[i]; u2[i] = u1[i]; u1[i] = zu[i]; }
            *(GAS v4u*)(H + (size_t)m * FF + c0) = pack8(o); }
    }
}
__device__ __forceinline__ void ret_norm_gate_phase(int gw, int NGW, int lane, bf16* O, const bf16* proj) {
    for (int m = gw; m < M; m += NGW) {
        GAS v4u* orow = (GAS v4u*)(O + (size_t)m * RV); const GAS v4u* grow = (const GAS v4u*)(proj + (size_t)m * RPROJ + 8192);
        v4u ow[8], gwv[8];
#pragma unroll
        for (int j = 0; j < 8; ++j) { ow[j] = orow[lane + 64 * j]; gwv[j] = grow[lane + 64 * j]; }
#pragma unroll
        for (int j = 0; j < 8; ++j) {
            float ov[8], gv[8], t[8]; unpack8(ow[j], ov); unpack8(gwv[j], gv); float sq = 0.f;
#pragma unroll
            for (int i = 0; i < 8; ++i) sq += ov[i] * ov[i];
            const float r = rsqrtf(wave_sum(sq) * (1.0f / 512.0f) + EPS);
#pragma unroll
            for (int i = 0; i < 8; ++i) t[i] = silu_f(gv[i]) * ov[i] * r;
            orow[lane + 64 * j] = pack8(t); }
    }
}
__device__ __forceinline__ void ln_stats_phase(int gw, int NGW, int lane, const bf16* V, float* mu, float* rstd) {
    for (int m = gw; m < M; m += NGW) {
        const GAS v4u* vr = (const GAS v4u*)(V + (size_t)m * GH); float a1 = 0.f, a2 = 0.f;
#pragma unroll
        for (int j = 0; j < 12; ++j) { float f[8]; const v4u w = vr[lane + 64 * j]; unpack8(w, f);
#pragma unroll
            for (int i = 0; i < 8; ++i) { a1 += f[i]; a2 += f[i] * f[i]; } }
        const float mean = wave_sum(a1) * (1.0f / GH), var = wave_sum(a2) * (1.0f / GH) - mean * mean;
        if (lane == 0) { mu[m] = mean; rstd[m] = rsqrtf(fmaxf(var, 0.f) + EPS); }
    }
}
__device__ __forceinline__ void gating_phase(LAS unsigned char* lds, int vcu, int G, int tid, bf16* U, const bf16* V, const float* s1, const float* s2,
                                             const float* lng, const float* lnb, const float* ws, const float* bs) {
    constexpr int WSP = 272, VTP = 576, OFF_WS = 0, OFF_VT = 128 * WSP, NUNITS = 8 * 128 * 3;
    const int lane = tid & 63, wid = __builtin_amdgcn_readfirstlane(tid >> 6), th = wid >> 2, dq = wid & 3;
    const int l31 = lane & 31, h = lane >> 5, blk = (lane >> 4) & 1, q = (lane & 15) >> 2, p = lane & 3;
    const int dchunk = tid & 31, rg = tid >> 5;
    const int vpos = 32 * (dchunk >> 2) + 16 * (dchunk & 1) + 4 * ((dchunk & 3) >> 1);
    LAS const unsigned char* vt_rd = lds + OFF_VT + (8 * h + q) * VTP + (64 * dq + 16 * blk + 4 * p) * 2;
    LAS const unsigned char* ws_rd = lds + OFF_WS + (64 * th + l31) * WSP + 16 * h;
    int gcur = -1; float bsv[2] = {0.f, 0.f};
    v4u vreg[8];
    int u = vcu;
    if (u < NUNITS) { const int g = u & 7, rest = u >> 3, ci = rest / 3, cb = rest % 3; const bf16* vp = V + (size_t)(ci * 128 + rg) * GH + g * 768 + cb * 256 + 8 * dchunk;
#pragma unroll
        for (int ps = 0; ps < 8; ++ps) vreg[ps] = *(const GAS v4u*)(vp + (size_t)(16 * ps) * GH); }
    for (; u < NUNITS; u += G) {
        const int g = u & 7, rest = u >> 3, ci = rest / 3, cb = rest % 3, m0 = ci * 128, ch0 = g * 768 + cb * 256;
        if (g != gcur) {
            for (int i = tid; i < 128 * 16; i += NWAVES * 64) { const int t = i >> 4, c8 = (i & 15) * 8; const GAS f32x4* wp = (const GAS f32x4*)(ws + ((size_t)g * 128 + t) * 128 + c8);
                const f32x4 a = wp[0], b = wp[1]; float f[8] = {a.x, a.y, a.z, a.w, b.x, b.y, b.z, b.w};
#pragma unroll
                for (int k = 0; k < 8; ++k) f[k] = (c8 + k <= t) ? f[k] : 0.f;
                *(LAS v4u*)(lds + OFF_WS + t * WSP + c8 * 2) = pack8(f); }
            bsv[0] = bs[g * 128 + 64 * th + l31]; bsv[1] = bs[g * 128 + 64 * th + 32 + l31]; gcur = g;
        }
        {
            const GAS f32x4* gp = (const GAS f32x4*)(lng + ch0 + 8 * dchunk); const GAS f32x4* bp = (const GAS f32x4*)(lnb + ch0 + 8 * dchunk);
            const f32x4 ga = gp[0], gb = gp[1], ba = bp[0], bb = bp[1];
            const float gg[8] = {ga.x, ga.y, ga.z, ga.w, gb.x, gb.y, gb.z, gb.w}, bb8[8] = {ba.x, ba.y, ba.z, ba.w, bb.x, bb.y, bb.z, bb.w};
#pragma unroll
            for (int ps = 0; ps < 8; ++ps) { const int s = rg + 16 * ps, m = m0 + s; const float mu = s1[m], rstd = s2[m];
                float f[8]; unpack8(vreg[ps], f);
#pragma unroll
                for (int k = 0; k < 8; ++k) f[k] = (f[k] - mu) * rstd * gg[k] + bb8[k];
                LAS unsigned char* wp = lds + OFF_VT + s * VTP + vpos * 2;
                *(LAS v2u*)wp = (v2u){pkbf(f[0], f[1]), pkbf(f[2], f[3])}; *(LAS v2u*)(wp + 16) = (v2u){pkbf(f[4], f[5]), pkbf(f[6], f[7])}; }
        }
        __syncthreads();
        const int un = u + G;
        if (un < NUNITS) { const int g2 = un & 7, rest2 = un >> 3, ci2 = rest2 / 3, cb2 = rest2 % 3; const bf16* vp = V + (size_t)(ci2 * 128 + rg) * GH + g2 * 768 + cb2 * 256 + 8 * dchunk;
#pragma unroll
            for (int ps = 0; ps < 8; ++ps) vreg[ps] = *(const GAS v4u*)(vp + (size_t)(16 * ps) * GH); }
        v4u ureg[2][2][2];
#pragma unroll
        for (int dt = 0; dt < 2; ++dt)
#pragma unroll
            for (int tt = 0; tt < 2; ++tt) { const GAS v4u* up = (const GAS v4u*)(U + (size_t)(m0 + 64 * th + 32 * tt + l31) * GH + ch0 + 64 * dq + 32 * dt + 16 * h); ureg[dt][tt][0] = up[0]; ureg[dt][tt][1] = up[1]; }
        f32x16 acc[2][2];
#pragma unroll
        for (int dt = 0; dt < 2; ++dt)
#pragma unroll
            for (int tt = 0; tt < 2; ++tt) acc[dt][tt] = zero16();
#pragma unroll
        for (int ks = 0; ks < 8; ++ks) {
            if (16 * ks <= 64 * th + 63) {
                bf16x8 af[2], bfr[2];
#pragma unroll
                for (int dt = 0; dt < 2; ++dt) af[dt] = cat8(tr_rd(vt_rd + (16 * ks) * VTP + dt * 64), tr_rd(vt_rd + (16 * ks + 4) * VTP + dt * 64));
#pragma unroll
                for (int tt = 0; tt < 2; ++tt) bfr[tt] = *(LAS const bf16x8*)(ws_rd + (32 * tt) * WSP + 32 * ks);
#pragma unroll
                for (int dt = 0; dt < 2; ++dt)
#pragma unroll
                    for (int tt = 0; tt < 2; ++tt) if (16 * ks <= 64 * th + 32 * tt + 31) acc[dt][tt] = MFMA32(af[dt], bfr[tt], acc[dt][tt]);
            }
        }
#pragma unroll
        for (int dt = 0; dt < 2; ++dt)
#pragma unroll
            for (int tt = 0; tt < 2; ++tt) { float uv[16], o[16]; { float a8[8], b8[8]; unpack8(ureg[dt][tt][0], a8); unpack8(ureg[dt][tt][1], b8);
#pragma unroll
                    for (int k = 0; k < 8; ++k) { uv[k] = a8[k]; uv[8 + k] = b8[k]; } }
#pragma unroll
                for (int i = 0; i < 16; ++i) o[i] = uv[i] * (acc[dt][tt][i] + bsv[tt]);
                GAS v4u* op = (GAS v4u*)(U + (size_t)(m0 + 64 * th + 32 * tt + l31) * GH + ch0 + 64 * dq + 32 * dt + 16 * h);
                v4u w0, w1; w0.x = pkbf(o[0], o[1]); w0.y = pkbf(o[2], o[3]); w0.z = pkbf(o[4], o[5]); w0.w = pkbf(o[6], o[7]); w1.x = pkbf(o[8], o[9]); w1.y = pkbf(o[10], o[11]); w1.z = pkbf(o[12], o[13]); w1.w = pkbf(o[14], o[15]);
                op[0] = w0; op[1] = w1; }
        __syncthreads();
    }
}

__device__ __forceinline__ unsigned offb(unsigned row, unsigned ch) { return 256u * row + 16u * (ch ^ (((row & 3u) << 2) | ((row >> 2) & 3u))); }
__device__ __forceinline__ void retention_phase(LAS unsigned char* lds, int vcu, int G, int tid, const bf16* proj, bf16* oraw) {
    constexpr int OFF_Q = 0, OFF_K = 32768, OFF_V = 65536, VP = 192, OFF_R = OFF_V + 128 * VP, RP = 528, PP = 272;
    static_assert(OFF_R + 64 * RP <= RING_BYTES && 128 * PP <= OFF_V, "retention LDS map");
    const int lane = tid & 63, wid = __builtin_amdgcn_readfirstlane(tid >> 6), wh = wid >> 1, wl = wid & 1;
    const int l31 = lane & 31, h = lane >> 5, blk = (lane >> 4) & 1, q = (lane & 15) >> 2, p = lane & 3;
    const int qch = tid & 15, qr = tid >> 4;
    const int vch = tid & 7, vr = tid >> 3;
    const int vpos = 32 * (vch >> 2) + 16 * (vch & 1) + 4 * ((vch & 3) >> 1);
    const unsigned xsw = (((unsigned)l31 & 3u) << 2) | (((unsigned)l31 >> 2) & 3u);
    const unsigned kfA = OFF_K + 256u * (32u * wh + l31) + 16u * ((unsigned)h ^ xsw);
    const unsigned q0A = OFF_Q + 256u * (64u * wl + l31) + 16u * ((unsigned)h ^ xsw);
    const unsigned rfA = OFF_R + (32u * wl + l31) * RP + 16u * h;
    const unsigned ccK = 4u * wh + 2u * blk + ((unsigned)p >> 1);
    const unsigned katA = OFF_K + 256u * (8u * h + q) + 16u * (ccK ^ ((((unsigned)q) << 2) | (2u * h))) + 8u * (p & 1);
    const unsigned katB = OFF_K + 256u * (8u * h + q + 4u) + 16u * (ccK ^ ((((unsigned)q) << 2) | (2u * h + 1u))) + 8u * (p & 1);
    const unsigned vtA = OFF_V + (8u * h + q) * VP + (32u * wl + 16u * blk + 4u * p) * 2u;
    const unsigned pfA = (32u * wh + l31) * PP + 16u * h;
    for (int unit = vcu; unit < 256; unit += G) {
        const int bh = unit >> 3, sl = unit & 7, b = bh >> 3, hd = bh & 7;
        const float lg = log1pf(-exp2f(-5.0f - (float)hd));
        const float cd = expf(128.0f * lg);
        const bf16* qg = proj + (size_t)(b * SEQ) * RPROJ + hd * 256; const bf16* kg = qg + 2048; const bf16* vg = proj + (size_t)(b * SEQ) * RPROJ + 4096 + hd * 512 + sl * 64;
        for (int i = tid; i < 64 * RP / 16; i += NWAVES * 64) ((LAS v4u*)(lds + OFF_R))[i] = (v4u){0u, 0u, 0u, 0u};
        f32x16 Racc[2] = {zero16(), zero16()}, X = zero16();
        v4u qreg[4], kreg[4], vreg[2];
#pragma unroll
        for (int i = 0; i < 4; ++i) { qreg[i] = *(const GAS v4u*)(qg + (size_t)(qr + 32 * i) * RPROJ + 8 * qch); kreg[i] = *(const GAS v4u*)(kg + (size_t)(qr + 32 * i) * RPROJ + 8 * qch); }
#pragma unroll
        for (int i = 0; i < 2; ++i) vreg[i] = *(const GAS v4u*)(vg + (size_t)(vr + 64 * i) * RPROJ + 8 * vch);
        __syncthreads();
        for (int ci = 0; ci < 32; ++ci) {
            const int m0 = b * SEQ + ci * 128;
            f32x16 S[2] = {zero16(), zero16()};
#pragma unroll
            for (int st = 0; st < 2; ++st) {
#pragma unroll
                for (int i = 0; i < 4; ++i) { *(LAS v4u*)(lds + OFF_Q + offb(qr + 32 * i, qch)) = qreg[i]; *(LAS v4u*)(lds + OFF_K + offb(qr + 32 * i, qch)) = kreg[i]; }
                if (st == 0) {
#pragma unroll
                    for (int i = 0; i < 2; ++i) { const int s = vr + 64 * i; const float sc = expf((float)(127 - s) * lg); float f[8]; unpack8(vreg[i], f);
#pragma unroll
                        for (int k = 0; k < 8; ++k) f[k] *= sc;
                        LAS unsigned char* wp = lds + OFF_V + s * VP + vpos * 2;
                        *(LAS v2u*)wp = (v2u){pkbf(f[0], f[1]), pkbf(f[2], f[3])}; *(LAS v2u*)(wp + 16) = (v2u){pkbf(f[4], f[5]), pkbf(f[6], f[7])}; }
                }
                { const int cn = (st == 0) ? ci : ci + 1, dk0 = (st == 0) ? 128 : 0;
                  if (cn < 32) {
#pragma unroll
                      for (int i = 0; i < 4; ++i) { qreg[i] = *(const GAS v4u*)(qg + (size_t)(cn * 128 + qr + 32 * i) * RPROJ + dk0 + 8 * qch); kreg[i] = *(const GAS v4u*)(kg + (size_t)(cn * 128 + qr + 32 * i) * RPROJ + dk0 + 8 * qch); }
                      if (st == 1) {
#pragma unroll
                          for (int i = 0; i < 2; ++i) vreg[i] = *(const GAS v4u*)(vg + (size_t)(cn * 128 + vr + 64 * i) * RPROJ + 8 * vch); } } }
                __syncthreads();
#pragma unroll
                for (int i = 0; i < 16; ++i) Racc[st][i] *= cd;
#pragma unroll 2
                for (int ks = 0; ks < 8; ++ks) {
                    const unsigned kx = (unsigned)ks << 5;
                    const bf16x8 kf = *(LAS const bf16x8*)(lds + (kfA ^ kx));
                    const bf16x8 q0 = *(LAS const bf16x8*)(lds + (q0A ^ kx));
                    const bf16x8 q1 = *(LAS const bf16x8*)(lds + (q0A ^ kx) + 8192);
                    S[0] = MFMA32(kf, q0, S[0]); S[1] = MFMA32(kf, q1, S[1]);
                    const bf16x8 rf = *(LAS const bf16x8*)(lds + rfA + (128 * st + 16 * ks) * 2);
                    const bf16x8 qx = *(LAS const bf16x8*)(lds + (kfA ^ kx) - (OFF_K - OFF_Q));
                    X = MFMA32(rf, qx, X);
                    const bf16x8 ka = cat8(tr_rd(lds + katA + 4096 * ks), tr_rd(lds + katB + 4096 * ks));
                    const bf16x8 vb = cat8(tr_rd(lds + vtA + 16 * VP * ks), tr_rd(lds + vtA + 16 * VP * ks + 4 * VP));
                    Racc[st] = MFMA32(ka, vb, Racc[st]);
                }
                __syncthreads();
            }
#pragma unroll
            for (int jj = 0; jj < 2; ++jj) { const int c = 64 * wl + 32 * jj + l31;
#pragma unroll
                for (int g4 = 0; g4 < 4; ++g4) { const int s0 = 32 * wh + 8 * g4 + 4 * h; float f[4];
#pragma unroll
                    for (int e = 0; e < 4; ++e) f[e] = (c >= s0 + e) ? S[jj][4 * g4 + e] : 0.f;
                    *(LAS v2u*)(lds + c * PP + s0 * 2) = (v2u){pkbf(f[0], f[1]), pkbf(f[2], f[3])}; } }
#pragma unroll
            for (int st = 0; st < 2; ++st)
#pragma unroll
                for (int g4 = 0; g4 < 4; ++g4) { const int dk0 = 128 * st + 32 * wh + 8 * g4 + 4 * h;
                    *(LAS v2u*)(lds + OFF_R + (32 * wl + l31) * RP + dk0 * 2) = (v2u){pkbf(Racc[st][4 * g4], Racc[st][4 * g4 + 1]), pkbf(Racc[st][4 * g4 + 2], Racc[st][4 * g4 + 3])}; }
            __syncthreads();
            f32x16 I = zero16();
#pragma unroll
            for (int ks = 0; ks < 8; ++ks) {
                const bf16x8 va = cat8(tr_rd(lds + vtA + 16 * VP * ks), tr_rd(lds + vtA + 16 * VP * ks + 4 * VP));
                const bf16x8 pf = *(LAS const bf16x8*)(lds + pfA + 32 * ks);
                I = MFMA32(va, pf, I);
            }
            { const int c = 32 * wh + l31; const float sI = expf((float)(c - 127) * lg), sX = expf((float)(c + 1) * lg); float o[16];
#pragma unroll
              for (int i = 0; i < 16; ++i) { o[i] = sI * I[i] + sX * X[i]; }
              GAS v4u* op = (GAS v4u*)(oraw + (size_t)(m0 + c) * RV + hd * 512 + sl * 64 + 32 * wl + 16 * h);
              v4u w0, w1; w0.x = pkbf(o[0], o[1]); w0.y = pkbf(o[2], o[3]); w0.z = pkbf(o[4], o[5]); w0.w = pkbf(o[6], o[7]); w1.x = pkbf(o[8], o[9]); w1.y = pkbf(o[10], o[11]); w1.z = pkbf(o[12], o[13]); w1.w = pkbf(o[14], o[15]);
              op[0] = w0; op[1] = w1; X = zero16(); }
            __syncthreads();
        }
    }
}
struct Args { const void* in[18]; float* out; unsigned char* ws; int ph_lo, ph_hi; };
constexpr int N_PHASES = 19;
__global__ void __launch_bounds__(NWAVES * 64, 2) mega_fwd(Args args) {
    extern __shared__ __attribute__((aligned(16))) unsigned char lds_raw[];
    LAS unsigned char* lds = (LAS unsigned char*)lds_raw;
    volatile LAS unsigned* MISC = (volatile LAS unsigned*)(lds + MISC_OFF);
    const int tid = threadIdx.x, lane = tid & 63, wave = __builtin_amdgcn_readfirstlane(tid >> 6);
    const int G = gridDim.x, bx = blockIdx.x, vcu = (G % 8 == 0) ? (bx % 8) * (G / 8) + bx / 8 : bx;
    const int gw = vcu * NWAVES + wave, NGW = G * NWAVES;
    unsigned char* ws = args.ws;
    gu32* ctl = (gu32*)(ws + WS_CTL);
    for (int u = tid; u < (LDS_BYTES - LDSCTL_OFF) / 4; u += NWAVES * 64) ((LAS unsigned*)(lds + LDSCTL_OFF))[u] = 0u;
    __syncthreads();
    XcdBarrier bar = xcd_barrier_post((unsigned*)(ctl + CW_BAR), MISC + 8);
    const float* x = (const float*)args.in[0]; const int* positions = (const int*)args.in[1];
    const float* mix_pre_g = (const float*)args.in[2]; const float* mix_post_g = (const float*)args.in[3];
    const float* gmlp_w_in = (const float*)args.in[4]; const float* gmlp_ln_g = (const float*)args.in[5]; const float* gmlp_ln_b = (const float*)args.in[6];
    const float* gmlp_w_s = (const float*)args.in[7]; const float* gmlp_b_s = (const float*)args.in[8]; const float* gmlp_w_out = (const float*)args.in[9];
    const float* ret_w_in = (const float*)args.in[10]; const float* ret_w_out = (const float*)args.in[11];
    const float* ffn_pre_g = (const float*)args.in[12]; const float* ffn_post_g = (const float*)args.in[13];
    const float* ffn_w_up = (const float*)args.in[14]; const float* ffn_conv_w = (const float*)args.in[15]; const float* ffn_conv_b = (const float*)args.in[16]; const float* ffn_w_down = (const float*)args.in[17];
    float* out = args.out;
    bf16* WA = (bf16*)(ws + WS_WA); bf16* WB = (bf16*)(ws + WS_WB); bf16* HN = (bf16*)(ws + WS_HN); bf16* BIG = (bf16*)(ws + WS_BIG); bf16* H2 = (bf16*)(ws + WS_H2);
    float* st_s1 = (float*)(ws + WS_STATS + ST_S1); float* st_s2 = (float*)(ws + WS_STATS + ST_S2);
    const int lo = args.ph_lo, hi = args.ph_hi;
#define IN(k) (lo <= (k) && (k) < hi)
#define SEAM(k) do { if (IN(k) && IN((k) + 1)) xcd_barrier(bar); } while (0)
#define GEMM(EPI, Aptr, Bptr, Nn, Kk, Eobj) do { pg8::Gemm g_{(const pg8::bf16_t*)(Aptr), (const pg8::bf16_t*)(Bptr), M, (Nn), (Kk)}; pg8::StaticOrder S_; S_.init(M, (Nn), G, bx); \
        pg8::gemm_phase<EPI, pg8::StaticOrder, true, true>(lds, g_, S_, (Eobj)); } while (0)

    if (IN(0)) {
        convert_weight(gmlp_w_in, D, GD, WA, lds, gw, NGW, wave, lane);
        convert_weight(gmlp_w_out, GH, D, WB, lds, gw, NGW, wave, lane);
        first_norm_phase(gw, NGW, lane, x, mix_pre_g, HN);
    }
    SEAM(0);
    if (IN(1)) { pg8::EpiGeluSplit E{(pg8::bf16_t*)BIG, GH, GH, (size_t)M * GH}; GEMM(pg8::EpiGeluSplit, HN, WA, GD, D, E); }
    SEAM(1);
    if (IN(2)) { ln_stats_phase(gw, NGW, lane, BIG + (size_t)M * GH, st_s1, st_s2); }
    SEAM(2);
    if (IN(3)) {
        gating_phase(lds, vcu, G, tid, BIG, BIG + (size_t)M * GH, st_s1, st_s2, gmlp_ln_g, gmlp_ln_b, gmlp_w_s, gmlp_b_s);
        __syncthreads();
        convert_weight(ffn_w_up, D, FF2, WA, lds, gw, NGW, wave, lane);
    }
    SEAM(3);
    if (IN(4)) { pg8::EpiPlain E{(pg8::bf16_t*)HN, D}; GEMM(pg8::EpiPlain, BIG, WB, D, GH, E); }
    SEAM(4);
    if (IN(5)) {
        resid_norm_phase<true>(gw, NGW, lane, HN, x, out, mix_post_g, ffn_pre_g, HN);
        convert_weight(ffn_w_down, FF, D, WB, lds, gw, NGW, wave, lane);
    }
    SEAM(5);
    if (IN(6)) { pg8::EpiPlain E{(pg8::bf16_t*)BIG, FF2}; GEMM(pg8::EpiPlain, HN, WA, FF2, D, E); }
    SEAM(6);
    if (IN(7)) {
        conv_gate_phase(gw, NGW, lane, BIG, H2, ffn_conv_w, ffn_conv_b);
        convert_weight(ret_w_in, D, RPROJ, WA, lds, gw, NGW, wave, lane);
    }
    SEAM(7);
    if (IN(8)) { pg8::EpiPlain E{(pg8::bf16_t*)HN, D}; GEMM(pg8::EpiPlain, H2, WB, D, FF, E); }
    SEAM(8);
    if (IN(9)) {
        resid_norm_phase<true>(gw, NGW, lane, HN, out, out, ffn_post_g, mix_pre_g + D, HN);
        convert_weight(ret_w_out, RV, D, WB, lds, gw, NGW, wave, lane);
    }
    SEAM(9);
    if (IN(10)) { pg8::EpiRetIn E{(pg8::bf16_t*)BIG, RPROJ, positions}; GEMM(pg8::EpiRetIn, HN, WA, RPROJ, D, E); }
    SEAM(10);
    if (IN(11)) {
        retention_phase(lds, vcu, G, tid, BIG, H2);
        __syncthreads();
        convert_weight(ffn_w_up + (size_t)D * FF2, D, FF2, WA, lds, gw, NGW, wave, lane);
    }
    SEAM(11);
    if (IN(12)) { ret_norm_gate_phase(gw, NGW, lane, H2, BIG); }
    SEAM(12);
    if (IN(13)) { pg8::EpiPlain E{(pg8::bf16_t*)HN, D}; GEMM(pg8::EpiPlain, H2, WB, D, RV, E); }
    SEAM(13);
    if (IN(14)) {
        resid_norm_phase<true>(gw, NGW, lane, HN, out, out, mix_post_g + D, ffn_pre_g + D, HN);
        convert_weight(ffn_w_down + (size_t)FF * D, FF, D, WB, lds, gw, NGW, wave, lane);
    }
    SEAM(14);
    if (IN(15)) { pg8::EpiPlain E{(pg8::bf16_t*)BIG, FF2}; GEMM(pg8::EpiPlain, HN, WA, FF2, D, E); }
    SEAM(15);
    if (IN(16)) { conv_gate_phase(gw, NGW, lane, BIG, H2, ffn_conv_w + (size_t)3 * FF2, ffn_conv_b + FF2); }
    SEAM(16);
    if (IN(17)) { pg8::EpiPlain E{(pg8::bf16_t*)HN, D}; GEMM(pg8::EpiPlain, H2, WB, D, FF, E); }
    SEAM(17);
    if (IN(18)) { resid_norm_phase<false>(gw, NGW, lane, HN, out, out, ffn_post_g + D, nullptr, nullptr); }
#undef IN
#undef SEAM
#undef GEMM
}

extern "C" void kernel_launch(void* const* d_in, const int* in_sizes, int n_in, void* d_out, int out_size, void* d_ws, size_t ws_size, hipStream_t stream) {
    static int grid = 0;
    if (grid == 0) {
        if (n_in != 18 || in_sizes[0] != M * D || out_size != M * D || ws_size < WS_END) { fprintf(stderr, "kernel_launch: unexpected problem shape / workspace (n_in %d, in0 %d, out %d, ws %zu < %zu)\n", n_in, n_in > 0 ? in_sizes[0] : -1, out_size, ws_size, (size_t)WS_END); grid = -1; return; }
        int dev = 0, cus = 0, per_cu = 0;
        if (hipGetDevice(&dev) != hipSuccess || hipDeviceGetAttribute(&cus, hipDeviceAttributeMultiprocessorCount, dev) != hipSuccess) { fprintf(stderr, "kernel_launch: device query failed\n"); grid = -1; return; }
        if (hipFuncSetAttribute((const void*)mega_fwd, hipFuncAttributeMaxDynamicSharedMemorySize, LDS_BYTES) != hipSuccess) { fprintf(stderr, "kernel_launch: hipFuncSetAttribute failed\n"); grid = -1; return; }
        if (hipOccupancyMaxActiveBlocksPerMultiprocessor(&per_cu, (const void*)mega_fwd, NWAVES * 64, LDS_BYTES) != hipSuccess || per_cu < 1) fprintf(stderr, "kernel_launch: note: occupancy query reports %d workgroups per CU\n", per_cu);
        (void)hipGetLastError();
        grid = cus;
    }
    if (grid < 0) return;
    if (hipMemsetAsync((char*)d_ws, 0, ZERO_BYTES, stream) != hipSuccess) { fprintf(stderr, "kernel_launch: memset failed\n"); return; }
    Args a{};
    for (int i = 0; i < 18; ++i) a.in[i] = d_in[i];
    a.out = (float*)d_out; a.ws = (unsigned char*)d_ws; a.ph_lo = 0; a.ph_hi = N_PHASES;
    hipLaunchKernelGGL(mega_fwd, dim3(grid), dim3(NWAVES * 64), LDS_BYTES, stream, a);
    const hipError_t le = hipPeekAtLastError();
    if (le != hipSuccess) fprintf(stderr, "kernel_launch: launch failed: %s\n", hipGetErrorName(le));
}
```

```cpp
#include <hip/hip_runtime.h>
#include <cstdio>
#include <cstdint>
#define KNOB_BAL true
#define CVT_NT_LOADS 1
#define X_NT_LOADS 1
#define CVT_STAG 1
namespace pg8 {
#define PG8_LAS __attribute__((address_space(3)))
typedef unsigned short bf16_t;
typedef short bf16x8 __attribute__((ext_vector_type(8)));
typedef float f32x4 __attribute__((ext_vector_type(4)));
typedef unsigned u32x4 __attribute__((ext_vector_type(4)));
constexpr int BM = 256, BK = 64, HALF = 128, HTB = HALF * BK * 2  , STAGE_BYTES = 8 * HTB, NXCD = 8, WGM = 8;

__host__ __device__ __forceinline__ int lds_byte(int r, int c) { const int st = (r >> 4) * 2 + (c >> 5), rr = r & 15, cc = c & 31, ob = rr * 64 + cc * 2; return st * 1024 + (ob ^ (((ob >> 9) & 1) << 5)); }
__host__ __device__ __forceinline__ void stage_rc(int b, int& R, int& C) { const int st = b / 1024, sb = b % 1024, swz = sb ^ (((sb >> 9) & 1) << 5); R = (st >> 1) * 16 + swz / 64; C = (st & 1) * 32 + (swz % 64) / 2; }
__host__ __device__ __forceinline__ int perm32(int rho) { const int n = rho >> 4, i = rho & 15; return 8 * (i >> 2) + 4 * n + (i & 3); }

struct Unit { int pm, pn; };
struct Gemm { const bf16_t* A; const bf16_t* Bt; int M, N, K; };

struct StaticOrder {
    int nM, nN, nwg, G, c, wgm;
    __host__ __device__ void init(int M, int N, int G_, int c_, int wgm_ = WGM) { nM = M / BM; nN = N / BM; nwg = nM * nN; G = G_; c = c_; wgm = wgm_; }
    __host__ __device__ __forceinline__ bool next(int i, Unit& u) const {
        const long L = (long)i * G + c; if (L >= nwg) return false;
        int wgid = (int)L; { const int q = nwg / NXCD, r = nwg % NXCD, xcd = wgid % NXCD, off = wgid / NXCD; wgid = (xcd < r ? xcd * (q + 1) : r * (q + 1) + (xcd - r) * q) + off; }
        const int nig = wgm * nN, gid = wgid / nig, fm = gid * wgm, gsz = (nM - fm) < wgm ? (nM - fm) : wgm;
        u.pm = fm + ((wgid % nig) % gsz); u.pn = (wgid % nig) / gsz; return true;
    }
    __device__ __forceinline__ void a_ready(const Unit&) const {}
    __device__ __forceinline__ void done(const Unit&) const {}
};

__device__ __forceinline__ unsigned cvt_pk_bf16(float lo, float hi) { unsigned r; asm volatile("v_cvt_pk_bf16_f32 %0, %1, %2" : "=v"(r) : "v"(lo), "v"(hi)); return r; }
typedef float f32x2 __attribute__((ext_vector_type(2)));
__device__ __forceinline__ f32x2 gelu_pk(f32x2 v) {
    f32x2 a; a.x = __builtin_amdgcn_fmed3f(__builtin_fabsf(v.x), 0.f, 6.0f); a.y = __builtin_amdgcn_fmed3f(__builtin_fabsf(v.y), 0.f, 6.0f);
    f32x2 p = a * 3.309384555905126e-05f + (-0.0007692287326790392f); p = p * a + 0.008080746047198772f; p = p * a + (-0.05341215059161186f); p = p * a + (-0.4587709307670593f);
    p = p * a + (-1.1512017250061035f); p = p * a + (-0.999993085861206f);
    f32x2 t; t.x = __builtin_amdgcn_exp2f(p.x); t.y = __builtin_amdgcn_exp2f(p.y);
    f32x2 sm; sm.x = v.x + __builtin_fabsf(v.x); sm.y = v.y + __builtin_fabsf(v.y);
    return sm * 0.5f - a * t;
}

__device__ __forceinline__ void gelu_pk4(f32x2 (&v)[4]) {
    f32x2 a[4], p[4], t[4];
#pragma unroll
    for (int i = 0; i < 4; ++i) { a[i].x = __builtin_amdgcn_fmed3f(__builtin_fabsf(v[i].x), 0.f, 6.0f); a[i].y = __builtin_amdgcn_fmed3f(__builtin_fabsf(v[i].y), 0.f, 6.0f); }
#pragma unroll
    for (int i = 0; i < 4; ++i) p[i] = a[i] * 3.309384555905126e-05f + (-0.0007692287326790392f);
    asm volatile("" : "+v"(p[0]), "+v"(p[1]), "+v"(p[2]), "+v"(p[3]));
#pragma unroll
    for (int i = 0; i < 4; ++i) p[i] = p[i] * a[i] + 0.008080746047198772f;
    asm volatile("" : "+v"(p[0]), "+v"(p[1]), "+v"(p[2]), "+v"(p[3]));
#pragma unroll
    for (int i = 0; i < 4; ++i) p[i] = p[i] * a[i] + (-0.05341215059161186f);
    asm volatile("" : "+v"(p[0]), "+v"(p[1]), "+v"(p[2]), "+v"(p[3]));
#pragma unroll
    for (int i = 0; i < 4; ++i) p[i] = p[i] * a[i] + (-0.4587709307670593f);
    asm volatile("" : "+v"(p[0]), "+v"(p[1]), "+v"(p[2]), "+v"(p[3]));
#pragma unroll
    for (int i = 0; i < 4; ++i) p[i] = p[i] * a[i] + (-1.1512017250061035f);
    asm volatile("" : "+v"(p[0]), "+v"(p[1]), "+v"(p[2]), "+v"(p[3]));
#pragma unroll
    for (int i = 0; i < 4; ++i) p[i] = p[i] * a[i] + (-0.999993085861206f);
    asm volatile("" : "+v"(p[0]), "+v"(p[1]), "+v"(p[2]), "+v"(p[3]));
#pragma unroll
    for (int i = 0; i < 4; ++i) { t[i].x = __builtin_amdgcn_exp2f(p[i].x); t[i].y = __builtin_amdgcn_exp2f(p[i].y); }
    asm volatile("" : "+v"(t[0]), "+v"(t[1]), "+v"(t[2]), "+v"(t[3]));
#pragma unroll
    for (int i = 0; i < 4; ++i) { f32x2 sm; sm.x = v[i].x + __builtin_fabsf(v[i].x); sm.y = v[i].y + __builtin_fabsf(v[i].y); v[i] = sm * 0.5f - a[i] * t[i]; }
}

template <int ACT  > struct EpiBf16 {
    static constexpr bool PERM = true, AFTER_DRAIN = false; static_assert(ACT == 0 || ACT == 1, "EpiBf16: ACT is 0 (none) or 1 (gelu_pk)");
    bf16_t* O; int ldc; const float* bias; int split_cols; size_t split_stride; float scale0;
    __device__ __forceinline__ void operator()(const f32x4 (&acc)[2][2][4][2], const Unit& u, int wr, int wc, int fr, int fq) const {
        const int row0 = u.pm * BM + wr * 64 + fr; int colt = u.pn * BM; bf16_t* base = O;
        float sc = 1.f; if (split_cols) { const int t = colt / split_cols; base += (size_t)t * split_stride; colt -= t * split_cols; if (t == 0) sc = scale0; }
        const int col0 = colt + wc * 32 + 8 * fq, bcol0 = u.pn * BM + wc * 32 + 8 * fq;
        f32x4 bv[2][2];
#pragma unroll
        for (int bj = 0; bj < 2; ++bj)
#pragma unroll
            for (int n = 0; n < 2; ++n) bv[bj][n] = bias ? *(const f32x4*)(bias + bcol0 + bj * HALF + 4 * n) : (f32x4){0.f, 0.f, 0.f, 0.f};
#pragma unroll
        for (int ai = 0; ai < 2; ++ai)
#pragma unroll
            for (int m = 0; m < 4; ++m) { bf16_t* rowp = base + (size_t)(row0 + ai * HALF + m * 16) * ldc + col0;
#pragma unroll
                for (int bj = 0; bj < 2; ++bj) { f32x4 v0 = acc[ai][bj][m][0] + bv[bj][0], v1 = acc[ai][bj][m][1] + bv[bj][1];
                    if (ACT == 1) { f32x2 a = gelu_pk((f32x2){v0[0], v0[1]}), b = gelu_pk((f32x2){v0[2], v0[3]}), c = gelu_pk((f32x2){v1[0], v1[1]}), d = gelu_pk((f32x2){v1[2], v1[3]});
                        v0 = (f32x4){a.x, a.y, b.x, b.y}; v1 = (f32x4){c.x, c.y, d.x, d.y}; }
                    v0 = v0 * sc; v1 = v1 * sc; u32x4 w; w.x = cvt_pk_bf16(v0[0], v0[1]); w.y = cvt_pk_bf16(v0[2], v0[3]); w.z = cvt_pk_bf16(v1[0], v1[1]); w.w = cvt_pk_bf16(v1[2], v1[3]);
                    *(u32x4*)(rowp + bj * HALF) = w; } }
    }
};
template <class T, class = void> struct HasKScale { static constexpr bool value = false; };
template <class T> struct HasKScale<T, decltype((void)T::KSCALE)> { static constexpr bool value = T::KSCALE; };
template <class T, class = void> struct HasRowScale { static constexpr bool value = false; };
template <class T> struct HasRowScale<T, decltype((void)T::ROWSCALE)> { static constexpr bool value = T::ROWSCALE; };
template <class T, class = void> struct HasAPerm4 { static constexpr bool value = false; };
template <class T> struct HasAPerm4<T, decltype((void)T::APERM4)> { static constexpr bool value = T::APERM4; };
template <class Epi, class Sched, bool ALIGN_EPI = false, bool SP2 = false, bool BAL = false, int EB = 0, int DIAG = 0, int VAR = 0>
__device__ __forceinline__ void gemm_phase(PG8_LAS unsigned char* lds, const Gemm g, const Sched& S, const Epi& E) {
    const int tid = threadIdx.x, wid = __builtin_amdgcn_readfirstlane(tid >> 6), lane = tid & 63, wr = wid >> 2, wc = wid & 3, fr = lane & 15, fq = lane >> 4;
    const int K = g.K, nt = K / BK;
    unsigned voffA[2], voffB[2];
#pragma unroll
    for (int i = 0; i < 2; ++i) { int R, C; stage_rc(tid * 16 + i * 8192, R, C); const int Rb = Epi::PERM ? ((R & ~31) + perm32(R & 31)) : R;
        const int Ra = HasAPerm4<Epi>::value ? ((R & 64) + 4 * (R & 15) + ((R >> 4) & 3)) : R;
        voffA[i] = (unsigned)(Ra * K + C) * 2u; voffB[i] = (unsigned)(Rb * K + C) * 2u; }
    const size_t kstep = (size_t)(BK * 2);
    const size_t hstep = (size_t)HALF * K * 2;
    const size_t tstep = 2 * hstep;
    const unsigned ldsw = (unsigned)wid * 1024u;
    const int aoff = lds_byte(wr * 64 + fr, fq * 8), boff = lds_byte(wc * 32 + fr, fq * 8);
#define PG8_SA(b, h) (((b) * 2 + (h)) * HTB)
#define PG8_SB(b, h) ((4 + (b) * 2 + (h)) * HTB)
#define PG8_STAGEX(aux, bufoff, gbase, voff) do { if constexpr (DIAG != 3) _Pragma("unroll") for (int _i = 0; _i < 2; ++_i) \
        __builtin_amdgcn_global_load_lds((const unsigned*)((const char*)(gbase) + (voff)[_i]), (PG8_LAS unsigned*)(lds + (bufoff) + ldsw + _i * 8192), 16, 0, (aux)); } while (0)
    constexpr int AUXA = (VAR & 32) ? 2 : 0, AUXB = (VAR & 16) ? 2 : 0;
#define PG8_LDA(dst, b, h) do { if (DIAG != 2 || never_) _Pragma("unroll") for (int m = 0; m < 4; ++m) _Pragma("unroll") for (int k = 0; k < 2; ++k) dst[m][k] = *(const PG8_LAS bf16x8*)(lds + PG8_SA(b, h) + aoff + m * 2048 + k * 1024); } while (0)
#define PG8_LDB(dst, b, h) do { if (DIAG != 2 || never_) _Pragma("unroll") for (int n = 0; n < 2; ++n) _Pragma("unroll") for (int k = 0; k < 2; ++k) dst[n][k] = *(const PG8_LAS bf16x8*)(lds + PG8_SB(b, h) + boff + n * 2048 + k * 1024); } while (0)
#define PG8_MMA(ai, bj, At, Bt) do { if constexpr (!(VAR & 1)) __builtin_amdgcn_s_setprio((VAR & 8) ? 3 : 1); _Pragma("unroll") for (int m = 0; m < 4; ++m) _Pragma("unroll") for (int n = 0; n < 2; ++n) _Pragma("unroll") for (int k = 0; k < 2; ++k) \
        acc[ai][bj][m][n] = __builtin_amdgcn_mfma_f32_16x16x32_bf16(Bt[n][k], At[m][k], acc[ai][bj][m][n], 0, 0, 0); if constexpr (!(VAR & 1)) __builtin_amdgcn_s_setprio(0); } while (0)
#define PG8_MMA_R(ai, bj, At, Bt, m0, m1) do { __builtin_amdgcn_s_setprio(1); _Pragma("unroll") for (int m = (m0); m < (m1); ++m) _Pragma("unroll") for (int n = 0; n < 2; ++n) _Pragma("unroll") for (int k = 0; k < 2; ++k) \
        acc[ai][bj][m][n] = __builtin_amdgcn_mfma_f32_16x16x32_bf16(Bt[n][k], At[m][k], acc[ai][bj][m][n], 0, 0, 0); __builtin_amdgcn_s_setprio(0); } while (0)
#define PG8_MMA_T(ai, bj, At, Bt, m0, m1) do { _Pragma("unroll") for (int m = (m0); m < (m1); ++m) _Pragma("unroll") for (int n = 0; n < 2; ++n) _Pragma("unroll") for (int k = 0; k < 2; ++k) \
        acc[ai][bj][m][n] = __builtin_amdgcn_mfma_f32_16x16x32_bf16(Bt[n][k], At[m][k], acc[ai][bj][m][n], 0, 0, 0); __builtin_amdgcn_s_setprio(0); } while (0)
#define PG8_MMA2_BAR(ai, At) do { if constexpr (EB == 0) { PG8_MMA(ai, 0, At, B0); PG8_MMA(ai, 1, At, B1); PG8_BAR; } \
        else { PG8_MMA(ai, 0, At, B0); PG8_MMA_R(ai, 1, At, B1, 0, 4 - EB); __builtin_amdgcn_s_setprio(3); PG8_SCHED; PG8_BAR; PG8_SCHED; PG8_MMA_T(ai, 1, At, B1, 4 - EB, 4); } } while (0)
#define PG8_WAIT_V(n) asm volatile("s_waitcnt vmcnt(" #n ")" ::: "memory")
#define PG8_WAIT_L(n) asm volatile("s_waitcnt lgkmcnt(" #n ")" ::: "memory")
#define PG8_BAR __builtin_amdgcn_s_barrier()
#define PG8_WLB(n) do { PG8_WAIT_V(n); if constexpr (VAR & 4) { PG8_BAR; PG8_WAIT_L(0); } else { PG8_WAIT_L(0); PG8_BAR; } } while (0)
#define PG8_SCHED __builtin_amdgcn_sched_barrier(0)
    Unit cur, nxt; int ui = 0;
    if (!S.next(0, cur)) return;
    f32x4 acc[2][2][4][2];
#pragma unroll
    for (int a = 0; a < 2; ++a)
#pragma unroll
        for (int b = 0; b < 2; ++b)
#pragma unroll
            for (int m = 0; m < 4; ++m)
#pragma unroll
                for (int n = 0; n < 2; ++n) acc[a][b][m][n] = (f32x4){0.f, 0.f, 0.f, 0.f};
    bf16x8 At[4][2], B0[2][2], B1[2][2];
    int never_ = 0; if constexpr (DIAG == 2) { asm volatile("" : "+s"(never_));
        _Pragma("unroll") for (int m = 0; m < 4; ++m) _Pragma("unroll") for (int k = 0; k < 2; ++k) At[m][k] = (bf16x8){0, 0, 0, 0, 0, 0, 0, 0};
        _Pragma("unroll") for (int n = 0; n < 2; ++n) _Pragma("unroll") for (int k = 0; k < 2; ++k) { B0[n][k] = (bf16x8){0, 0, 0, 0, 0, 0, 0, 0}; B1[n][k] = (bf16x8){0, 0, 0, 0, 0, 0, 0, 0}; } }
    const char* cA = (const char*)g.A + (size_t)(DIAG == 1 ? 0 : cur.pm) * tstep; const char* cB = (const char*)g.Bt + (size_t)(DIAG == 1 ? 0 : cur.pn) * tstep;
    S.a_ready(cur);
    if constexpr (SP2 && BAL) {
        PG8_STAGEX(AUXB, PG8_SB(0, 0), cB, voffB); PG8_STAGEX(AUXB, PG8_SB(0, 1), cB + hstep, voffB); PG8_STAGEX(AUXA, PG8_SA(0, 0), cA, voffA); PG8_STAGEX(AUXA, PG8_SA(0, 1), cA + hstep, voffA);
        if (wr == 1) PG8_BAR;
        PG8_WAIT_V(2); PG8_BAR;
        PG8_STAGEX(AUXB, PG8_SB(1, 0), cB + kstep, voffB); PG8_STAGEX(AUXB, PG8_SB(1, 1), cB + hstep + kstep, voffB);
        PG8_WAIT_V(4); PG8_BAR;
    } else if constexpr (SP2) {
        PG8_STAGEX(AUXB, PG8_SB(0, 0), cB, voffB); PG8_STAGEX(AUXB, PG8_SB(0, 1), cB + hstep, voffB); PG8_STAGEX(AUXA, PG8_SA(0, 0), cA, voffA); PG8_STAGEX(AUXA, PG8_SA(0, 1), cA + hstep, voffA);
        if (wr == 1) PG8_BAR;
        PG8_WAIT_V(2); PG8_BAR;
        PG8_STAGEX(AUXB, PG8_SB(1, 0), cB + kstep, voffB); PG8_STAGEX(AUXA, PG8_SA(1, 0), cA + kstep, voffA); PG8_STAGEX(AUXB, PG8_SB(1, 1), cB + hstep + kstep, voffB);
        PG8_WAIT_V(6); PG8_BAR;
    } else {
        PG8_STAGEX(AUXB, PG8_SB(0, 0), cB, voffB); PG8_STAGEX(AUXA, PG8_SA(0, 0), cA, voffA); PG8_STAGEX(AUXB, PG8_SB(0, 1), cB + hstep, voffB); PG8_STAGEX(AUXA, PG8_SA(0, 1), cA + hstep, voffA);
        if (wr == 1) PG8_BAR;
        PG8_WAIT_V(4); PG8_BAR;
        PG8_STAGEX(AUXB, PG8_SB(1, 0), cB + kstep, voffB); PG8_STAGEX(AUXA, PG8_SA(1, 0), cA + kstep, voffA); PG8_STAGEX(AUXB, PG8_SB(1, 1), cB + hstep + kstep, voffB);
        PG8_WAIT_V(6); PG8_BAR;
    }
    for (;;) {
        const bool has_next = S.next(ui + 1, nxt);
        const char* nA = has_next ? (const char*)g.A + (size_t)(DIAG == 1 ? 0 : nxt.pm) * tstep : cA; const char* nB = has_next ? (const char*)g.Bt + (size_t)(DIAG == 1 ? 0 : nxt.pn) * tstep : cB;
        for (int t = 0; t < nt; t += 2) {
            const bool last = (t == nt - 2);
            const char* a1 = cA + (size_t)(t + 1) * kstep;
            const char* a2 = last ? nA : cA + (size_t)(t + 2) * kstep; const char* b2 = last ? nB : cB + (size_t)(t + 2) * kstep;
            const char* a3 = a2 + kstep; const char* b3 = b2 + kstep;
            if (last && has_next) S.a_ready(nxt);
            if constexpr (SP2 && BAL) {
            if constexpr (VAR & 2) { PG8_STAGEX(AUXA, PG8_SA(1, 0), a1, voffA); PG8_STAGEX(AUXA, PG8_SA(1, 1), a1 + hstep, voffA); PG8_SCHED; } PG8_LDB(B0, 0, 0); PG8_LDB(B1, 0, 1); PG8_SCHED; PG8_LDA(At, 0, 0); if constexpr (!(VAR & 2)) { PG8_STAGEX(AUXA, PG8_SA(1, 0), a1, voffA); PG8_STAGEX(AUXA, PG8_SA(1, 1), a1 + hstep, voffA); }
            PG8_WLB(8); PG8_MMA2_BAR(0, At); PG8_SCHED;
            if constexpr (VAR & 2) { PG8_STAGEX(AUXB, PG8_SB(0, 0), b2, voffB); PG8_STAGEX(AUXB, PG8_SB(0, 1), b2 + hstep, voffB); PG8_SCHED; } PG8_LDA(At, 0, 1); if constexpr (!(VAR & 2)) { PG8_STAGEX(AUXB, PG8_SB(0, 0), b2, voffB); PG8_STAGEX(AUXB, PG8_SB(0, 1), b2 + hstep, voffB); }
            PG8_WLB(6); PG8_MMA2_BAR(1, At); PG8_SCHED;
            if constexpr (VAR & 2) { PG8_STAGEX(AUXA, PG8_SA(0, 0), a2, voffA); PG8_STAGEX(AUXA, PG8_SA(0, 1), a2 + hstep, voffA); PG8_SCHED; } PG8_LDB(B0, 1, 0); PG8_LDB(B1, 1, 1); PG8_SCHED; PG8_LDA(At, 1, 0); if constexpr (!(VAR & 2)) { PG8_STAGEX(AUXA, PG8_SA(0, 0), a2, voffA); PG8_STAGEX(AUXA, PG8_SA(0, 1), a2 + hstep, voffA); }
            PG8_WLB(8); PG8_MMA2_BAR(0, At); PG8_SCHED;
            if constexpr (VAR & 2) { PG8_STAGEX(AUXB, PG8_SB(1, 0), b3, voffB); PG8_STAGEX(AUXB, PG8_SB(1, 1), b3 + hstep, voffB); PG8_SCHED; } PG8_LDA(At, 1, 1); if constexpr (!(VAR & 2)) { PG8_STAGEX(AUXB, PG8_SB(1, 0), b3, voffB); PG8_STAGEX(AUXB, PG8_SB(1, 1), b3 + hstep, voffB); }
            PG8_WLB(6); PG8_MMA2_BAR(1, At); PG8_SCHED;
            if constexpr (HasKScale<Epi>::value) { if (((t + 2) & 7) == 0) { E.kscale(acc, ui, (t + 2) / 8 - 1, wr, fr); PG8_SCHED; } }
            (void)a3;
            } else if constexpr (SP2) {
            PG8_LDB(B0, 0, 0); PG8_LDB(B1, 0, 1); PG8_SCHED; PG8_LDA(At, 0, 0); PG8_STAGEX(AUXA, PG8_SA(1, 1), a1 + hstep, voffA);
            PG8_WAIT_V(8); PG8_WAIT_L(0); PG8_BAR; PG8_MMA(0, 0, At, B0); PG8_MMA(0, 1, At, B1); PG8_BAR; PG8_SCHED;
            PG8_LDA(At, 0, 1); PG8_STAGEX(AUXB, PG8_SB(0, 0), b2, voffB); PG8_STAGEX(AUXB, PG8_SB(0, 1), b2 + hstep, voffB); PG8_STAGEX(AUXA, PG8_SA(0, 0), a2, voffA);
            PG8_WAIT_V(8); PG8_WAIT_L(0); PG8_BAR; PG8_MMA(1, 0, At, B0); PG8_MMA(1, 1, At, B1); PG8_BAR; PG8_SCHED;
            PG8_LDB(B0, 1, 0); PG8_LDB(B1, 1, 1); PG8_SCHED; PG8_LDA(At, 1, 0); PG8_STAGEX(AUXA, PG8_SA(0, 1), a2 + hstep, voffA);
            PG8_WAIT_V(8); PG8_WAIT_L(0); PG8_BAR; PG8_MMA(0, 0, At, B0); PG8_MMA(0, 1, At, B1); PG8_BAR; PG8_SCHED;
            PG8_LDA(At, 1, 1); PG8_STAGEX(AUXB, PG8_SB(1, 0), b3, voffB); PG8_STAGEX(AUXB, PG8_SB(1, 1), b3 + hstep, voffB); PG8_STAGEX(AUXA, PG8_SA(1, 0), a3, voffA);
            PG8_WAIT_V(8); PG8_WAIT_L(0); PG8_BAR; PG8_MMA(1, 0, At, B0); PG8_MMA(1, 1, At, B1); PG8_BAR; PG8_SCHED;
            if constexpr (HasKScale<Epi>::value) { if (((t + 2) & 7) == 0) { E.kscale(acc, ui, (t + 2) / 8 - 1, wr, fr); PG8_SCHED; } }
            } else {
            PG8_LDB(B0, 0, 0); PG8_SCHED; PG8_LDA(At, 0, 0); PG8_STAGEX(AUXA, PG8_SA(1, 1), a1 + hstep, voffA);
            PG8_WAIT_L(8); PG8_BAR; PG8_WAIT_L(0); PG8_MMA(0, 0, At, B0); PG8_BAR; PG8_SCHED;
            PG8_LDB(B1, 0, 1); PG8_STAGEX(AUXB, PG8_SB(0, 0), b2, voffB);
            PG8_BAR; PG8_WAIT_L(0); PG8_MMA(0, 1, At, B1); PG8_BAR;
            PG8_LDA(At, 0, 1); PG8_STAGEX(AUXA, PG8_SA(0, 0), a2, voffA);
            PG8_BAR; PG8_WAIT_L(0); PG8_MMA(1, 0, At, B0); PG8_BAR; PG8_SCHED;
            PG8_STAGEX(AUXB, PG8_SB(0, 1), b2 + hstep, voffB);
            PG8_WAIT_V(6); PG8_BAR; PG8_MMA(1, 1, At, B1); PG8_BAR;
            PG8_LDB(B0, 1, 0); PG8_SCHED; PG8_LDA(At, 1, 0); PG8_STAGEX(AUXA, PG8_SA(0, 1), a2 + hstep, voffA);
            PG8_WAIT_L(8); PG8_BAR; PG8_WAIT_L(0); PG8_MMA(0, 0, At, B0); PG8_BAR; PG8_SCHED;
            PG8_LDB(B1, 1, 1); PG8_STAGEX(AUXB, PG8_SB(1, 0), b3, voffB);
            PG8_BAR; PG8_WAIT_L(0); PG8_MMA(0, 1, At, B1); PG8_BAR;
            PG8_LDA(At, 1, 1); PG8_STAGEX(AUXA, PG8_SA(1, 0), a3, voffA);
            PG8_BAR; PG8_WAIT_L(0); PG8_MMA(1, 0, At, B0); PG8_BAR; PG8_SCHED;
            PG8_STAGEX(AUXB, PG8_SB(1, 1), b3 + hstep, voffB);
            PG8_WAIT_V(6); PG8_BAR; PG8_MMA(1, 1, At, B1); PG8_BAR;
            }
        }
        if constexpr (ALIGN_EPI) { if (wr == 0) PG8_BAR; }
        if constexpr (HasRowScale<Epi>::value) E.prescale(acc, cur, wr, fr);
        if constexpr (!Epi::AFTER_DRAIN) { E(acc, cur, wr, wc, fr, fq); S.done(cur); }
        if (!has_next) break;
#pragma unroll
        for (int a = 0; a < 2; ++a)
#pragma unroll
            for (int b = 0; b < 2; ++b)
#pragma unroll
                for (int m = 0; m < 4; ++m)
#pragma unroll
                    for (int n = 0; n < 2; ++n) acc[a][b][m][n] = (f32x4){0.f, 0.f, 0.f, 0.f};
        cur = nxt; cA = nA; cB = nB; ++ui;
        if constexpr (ALIGN_EPI) { if (wr == 1) PG8_BAR; }
    }
    PG8_WAIT_V(0);
    if constexpr (!ALIGN_EPI) { if (wr == 0) PG8_BAR; }
    PG8_BAR;
    if constexpr (Epi::AFTER_DRAIN) { E.fused(acc, cur, wr, wc, fr, fq, lds, wid, lane); S.done(cur); }
#undef PG8_SA
#undef PG8_SB
#undef PG8_STAGEX
#undef PG8_LDA
#undef PG8_LDB
#undef PG8_MMA
#undef PG8_MMA_R
#undef PG8_WLB
#undef PG8_MMA_T
#undef PG8_MMA2_BAR
#undef PG8_WAIT_V
#undef PG8_WAIT_L
#undef PG8_BAR
#undef PG8_SCHED
}
}
namespace pg8 {
typedef float f32x2e __attribute__((ext_vector_type(2))); typedef __bf16 bf16x2e __attribute__((ext_vector_type(2)));
__device__ __forceinline__ float sum_fq(float v) {
    v += __builtin_bit_cast(float, __builtin_amdgcn_ds_swizzle(__builtin_bit_cast(int, v), 0x401F));
    const int idx = (int)(((threadIdx.x & 63u) ^ 32u) << 2);
    return v + __builtin_bit_cast(float, __builtin_amdgcn_ds_bpermute(idx, __builtin_bit_cast(int, v))); }
__device__ __forceinline__ unsigned pk_bf16(float lo, float hi) { f32x2e v = {lo, hi}; bf16x2e b = __builtin_convertvector(v, bf16x2e); return __builtin_bit_cast(unsigned, b); }
__device__ __forceinline__ void row_prescale(f32x4 (&acc)[2][2][4][2], const float* rs, int row0) {
#pragma unroll
    for (int ai = 0; ai < 2; ++ai)
#pragma unroll
        for (int m = 0; m < 4; ++m) { const float s = rs[row0 + ai * HALF + m * 16];
#pragma unroll
            for (int bj = 0; bj < 2; ++bj)
#pragma unroll
                for (int n = 0; n < 2; ++n) acc[ai][bj][m][n] = acc[ai][bj][m][n] * s; }
}
struct EpiPlain {
    static constexpr bool PERM = true, AFTER_DRAIN = false, NEEDS_ALIGN = false;
    bf16_t* O; int ldc;
    __device__ __forceinline__ void operator()(const f32x4 (&acc)[2][2][4][2], const Unit& u, int wr, int wc, int fr, int fq) const {
        const int row0 = u.pm * BM + wr * 64 + fr, col0 = u.pn * BM + wc * 32 + 8 * fq;
#pragma unroll
        for (int ai = 0; ai < 2; ++ai)
#pragma unroll
            for (int m = 0; m < 4; ++m) { bf16_t* rowp = O + (size_t)(row0 + ai * HALF + m * 16) * ldc + col0;
#pragma unroll
                for (int bj = 0; bj < 2; ++bj) { const f32x4 v0 = acc[ai][bj][m][0], v1 = acc[ai][bj][m][1];
                    u32x4 w; w.x = pk_bf16(v0[0], v0[1]); w.y = pk_bf16(v0[2], v0[3]); w.z = pk_bf16(v1[0], v1[1]); w.w = pk_bf16(v1[2], v1[3]);
                    *(u32x4*)(rowp + bj * HALF) = w; } }
    }
};
constexpr int GELU_TAB_N = 3072; constexpr float GELU_TAB_SCALE = 512.0f;
__device__ __forceinline__ void gelu_tab8(f32x4& v0, f32x4& v1, const PG8_LAS unsigned char* tab) {
    float v[8] = {v0[0], v0[1], v0[2], v0[3], v1[0], v1[1], v1[2], v1[3]}, fr[8], hv[8]; f32x2 e[8];
#pragma unroll
    for (int i = 0; i < 8; ++i) { const float av = __builtin_fabsf(v[i]), x = __builtin_fminf(av * GELU_TAB_SCALE, (float)GELU_TAB_N - 0.001f);
        e[i] = *(const PG8_LAS f32x2*)(tab + 8u * (unsigned)x); fr[i] = __builtin_amdgcn_fractf(x); hv[i] = 0.5f * v[i] + 0.5f * av; }
    asm volatile("" ::: "memory");
#pragma unroll
    for (int i = 0; i < 8; ++i) v[i] = hv[i] - (e[i].x + fr[i] * e[i].y);
    v0 = (f32x4){v[0], v[1], v[2], v[3]}; v1 = (f32x4){v[4], v[5], v[6], v[7]};
}
template <bool ST, bool TAB = false> struct EpiGeluSplitT {
    static constexpr bool PERM = true, AFTER_DRAIN = false, NEEDS_ALIGN = false;
    bf16_t* O; int ldc; int split_cols; size_t split_stride; float* part; int M_; const PG8_LAS unsigned char* tab;
    __device__ __forceinline__ void operator()(const f32x4 (&acc)[2][2][4][2], const Unit& u, int wr, int wc, int fr, int fq) const {
        const int row0 = u.pm * BM + wr * 64 + fr; int colt = u.pn * BM; bf16_t* base = O;
        const int t = colt / split_cols; base += (size_t)t * split_stride; colt -= t * split_cols;
        const int col0 = colt + wc * 32 + 8 * fq;
        float* pslot = part + ((size_t)((colt / BM) * 4 + wc) * M_) * 2;
#pragma unroll
        for (int ai = 0; ai < 2; ++ai)
#pragma unroll
            for (int m = 0; m < 4; ++m) { const int row = row0 + ai * HALF + m * 16; bf16_t* rowp = (t == 1) ? base + (size_t)(colt / BM) * M_ * BM + (size_t)row * BM + (wc * 32 + 8 * fq) : base + (size_t)row * ldc + col0;     float a1 = 0.f, a2 = 0.f; f32x2 s2 = {0.f, 0.f}, q2 = {0.f, 0.f};
#pragma unroll
                for (int bj = 0; bj < 2; ++bj) { f32x4 v0 = acc[ai][bj][m][0], v1 = acc[ai][bj][m][1];
                    if (TAB) gelu_tab8(v0, v1, tab);
                    else { f32x2 q[4] = {(f32x2){v0[0], v0[1]}, (f32x2){v0[2], v0[3]}, (f32x2){v1[0], v1[1]}, (f32x2){v1[2], v1[3]}}; gelu_pk4(q);
                      v0 = (f32x4){q[0].x, q[0].y, q[1].x, q[1].y}; v1 = (f32x4){q[2].x, q[2].y, q[3].x, q[3].y}; }
                    if (t == 1) {
                      const f32x2 p0 = {v0[0], v0[1]}, p1 = {v0[2], v0[3]}, p2 = {v1[0], v1[1]}, p3 = {v1[2], v1[3]};
                      s2 += (p0 + p1) + (p2 + p3); q2 = p0 * p0 + q2; q2 = p1 * p1 + q2; q2 = p2 * p2 + q2; q2 = p3 * p3 + q2; }
                    u32x4 w; w.x = pk_bf16(v0[0], v0[1]); w.y = pk_bf16(v0[2], v0[3]); w.z = pk_bf16(v1[0], v1[1]); w.w = pk_bf16(v1[2], v1[3]);
                    if (ST) *(u32x4*)(rowp + bj * HALF) = w; else asm volatile("" :: "v"(w)); }
                if (t == 1) { a1 = sum_fq(s2.x + s2.y); a2 = sum_fq(q2.x + q2.y);
                    if (fq == 0) { if (ST) *(f32x2*)(pslot + (size_t)row * 2) = (f32x2){a1, a2}; else asm volatile("" :: "v"(a1), "v"(a2)); } } }
    }
};
#ifndef KNOB_GELU_TAB
#define KNOB_GELU_TAB false
#endif
typedef EpiGeluSplitT<true, KNOB_GELU_TAB> EpiGeluSplit;
struct EpiRetIn {
    static constexpr bool PERM = true, AFTER_DRAIN = false, NEEDS_ALIGN = false;
    bf16_t* O; int M_; const int* pos;
    __device__ __forceinline__ void operator()(const f32x4 (&acc)[2][2][4][2], const Unit& u, int wr, int wc, int fr, int fq) const {
        const int row0 = u.pm * BM + wr * 64 + fr, col0 = u.pn * BM + wc * 32 + 8 * fq;
        const bool rope = u.pn < 16; const float ksc = (u.pn >= 8) ? 0.0625f : 1.0f;
        float fr_[2][4];
#pragma unroll
        for (int bj = 0; bj < 2; ++bj)
#pragma unroll
            for (int p = 0; p < 4; ++p) { const int i = 64 * bj + 16 * wc + 4 * fq + p; fr_[bj][p] = __builtin_amdgcn_exp2f(-(float)i * (13.287712379549449f / 127.0f)) * 0.15915494309189535f; }
#pragma unroll
        for (int ai = 0; ai < 2; ++ai)
#pragma unroll
            for (int m = 0; m < 4; ++m) { const int row = row0 + ai * HALF + m * 16; bf16_t* rowp = O + (size_t)u.pn * M_ * BM + (size_t)row * BM + (wc * 32 + 8 * fq);      const float pp = rope ? (float)pos[row] : 0.f;
#pragma unroll
                for (int bj = 0; bj < 2; ++bj) { f32x4 v0 = acc[ai][bj][m][0], v1 = acc[ai][bj][m][1];
                    if (rope) {
                        float x[8] = {v0[0], v0[1], v0[2], v0[3], v1[0], v1[1], v1[2], v1[3]};
#pragma unroll
                        for (int p = 0; p < 4; ++p) { float rev = pp * fr_[bj][p]; rev = __builtin_amdgcn_fractf(rev); const float sn = __builtin_amdgcn_sinf(rev), cs = __builtin_amdgcn_cosf(rev);
                            const float a = x[2 * p], b = x[2 * p + 1]; x[2 * p] = (a * cs - b * sn) * ksc; x[2 * p + 1] = (b * cs + a * sn) * ksc; }
                        v0 = (f32x4){x[0], x[1], x[2], x[3]}; v1 = (f32x4){x[4], x[5], x[6], x[7]}; }
                    u32x4 w; w.x = pk_bf16(v0[0], v0[1]); w.y = pk_bf16(v0[2], v0[3]); w.z = pk_bf16(v1[0], v1[1]); w.w = pk_bf16(v1[2], v1[3]);
                    *(u32x4*)(rowp + bj * HALF) = w; } }
    }
};
template <int CTRL> __device__ __forceinline__ float dppz(float v) { return __builtin_bit_cast(float, __builtin_amdgcn_update_dpp(0, __builtin_bit_cast(int, v), CTRL, 0xF, 0xF, true)); }
struct EpiConvGate {
    static constexpr bool PERM = true, AFTER_DRAIN = false, NEEDS_ALIGN = true;
    bf16_t* H; int ldh; const float* cw; const float* cb; float* halo; PG8_LAS unsigned char* tail; int N_, FF_; PG8_LAS float* wl;
    __device__ __forceinline__ void operator()(const f32x4 (&acc)[2][2][4][2], const Unit& u, int wr, int wc, int fr, int fq) const {
        const int cwl = wc * 32 + 8 * fq;
        PG8_LAS float* T = (PG8_LAS float*)tail;
        const int hc = u.pn * 128 + cwl, row0 = u.pm * BM + wr * 64 + fr;
        { const int r = wr * 4 + wc, c2 = fq * 16 + fr;
          const float* src = (r < 6) ? cw + (size_t)(r % 3) * N_ + (r / 3) * FF_ + u.pn * 128 + 2 * c2 : cb + (r - 6) * FF_ + u.pn * 128 + 2 * c2;
          const float sc = (r < 3 || r == 6) ? -1.4426950408889634f : -0.6931471805599453f;
          const f32x2 v = *(const f32x2*)src; *(PG8_LAS f32x2*)(wl + r * 128 + 2 * c2) = v * sc; }
        if (fr >= 14) {
#pragma unroll
            for (int ai = 0; ai < 2; ++ai)
#pragma unroll
                for (int bj = 0; bj < 2; ++bj)
#pragma unroll
                    for (int n = 0; n < 2; ++n) *(PG8_LAS f32x4*)(T + (((2 * ai + wr) * 2 + (fr - 14)) * 256 + 128 * bj + cwl + 4 * n)) = acc[ai][bj][3][n];
        }
        if (wr == 0 && fr < 2) {
#pragma unroll
            for (int bj = 0; bj < 2; ++bj)
#pragma unroll
                for (int n = 0; n < 2; ++n) *(f32x4*)(halo + ((size_t)(u.pm * 4 + fr)) * N_ + u.pn * 256 + 128 * bj + cwl + 4 * n) = acc[0][bj][0][n];
        }
        if (wr == 1 && fr >= 14) {
#pragma unroll
            for (int bj = 0; bj < 2; ++bj)
#pragma unroll
                for (int n = 0; n < 2; ++n) *(f32x4*)(halo + ((size_t)(u.pm * 4 + fr - 12)) * N_ + u.pn * 256 + 128 * bj + cwl + 4 * n) = acc[1][bj][3][n];
        }
        asm volatile("s_waitcnt lgkmcnt(0)" ::: "memory"); __builtin_amdgcn_s_barrier(); asm volatile("" ::: "memory");
#pragma unroll
        for (int n = 0; n < 2; ++n) {
            f32x4 w[2][3], bb[2];
#pragma unroll
            for (int bj = 0; bj < 2; ++bj) {
#pragma unroll
                for (int t = 0; t < 3; ++t) w[bj][t] = *(const PG8_LAS f32x4*)(wl + (3 * bj + t) * 128 + cwl + 4 * n);
                bb[bj] = *(const PG8_LAS f32x4*)(wl + (6 + bj) * 128 + cwl + 4 * n); }
#pragma unroll
            for (int ai = 0; ai < 2; ++ai) {
                f32x4 o1[2], o2[2];
                if (ai == 0 && wr == 0) { o1[0] = o1[1] = o2[0] = o2[1] = (f32x4){0.f, 0.f, 0.f, 0.f}; }
                else { const int pb = 2 * ai + wr - 1;
#pragma unroll
                    for (int bj = 0; bj < 2; ++bj) { const f32x4 t15 = *(const PG8_LAS f32x4*)(T + ((pb * 2 + 1) * 256 + 128 * bj + cwl + 4 * n)), t14 = *(const PG8_LAS f32x4*)(T + ((pb * 2 + 0) * 256 + 128 * bj + cwl + 4 * n));
                        const f32x4 z4 = (f32x4){0.f, 0.f, 0.f, 0.f}; o1[bj] = (fr == 0) ? t15 : z4; o2[bj] = (fr == 0) ? t14 : ((fr == 1) ? t15 : z4); } }
#pragma unroll
                for (int m = 0; m < 4; ++m) {
                    f32x4 zc[2];
#pragma unroll
                    for (int bj = 0; bj < 2; ++bj) { const f32x4 cur = acc[ai][bj][m][n]; f32x4 r;
#pragma unroll
                        for (int e = 0; e < 4; ++e) {
                            float v = bb[bj][e] + w[bj][2][e] * cur[e];
                            asm("v_fmac_f32_dpp %0, %1, %2 row_shr:1 row_mask:0xf bank_mask:0xf bound_ctrl:1" : "+v"(v) : "v"(cur[e]), "v"(w[bj][1][e]));
                            asm("v_fmac_f32_dpp %0, %1, %2 row_shr:2 row_mask:0xf bank_mask:0xf bound_ctrl:1" : "+v"(v) : "v"(cur[e]), "v"(w[bj][0][e]));
                            if (m == 0) { v += w[bj][1][e] * o1[bj][e]; v += w[bj][0][e] * o2[bj][e]; }
                            else { const float pv = acc[ai][bj][m - 1][n][e];
                                asm("v_fmac_f32_dpp %0, %1, %2 row_shl:15 row_mask:0xf bank_mask:0xf bound_ctrl:1" : "+v"(v) : "v"(pv), "v"(w[bj][1][e]));
                                asm("v_fmac_f32_dpp %0, %1, %2 row_shl:14 row_mask:0xf bank_mask:0xf bound_ctrl:1" : "+v"(v) : "v"(pv), "v"(w[bj][0][e])); }
                            r[e] = v; }
                        zc[bj] = r; }
                    float hv[4];
#pragma unroll
                    for (int e = 0; e < 4; ++e) { const float g = zc[0][e]; hv[e] = g * __builtin_amdgcn_rcpf(1.0f + __builtin_amdgcn_exp2f(g)) * zc[1][e]; }
                    typedef unsigned u32x2 __attribute__((ext_vector_type(2)));
                    *(u32x2*)(H + (size_t)(row0 + ai * HALF + m * 16) * ldh + hc + 4 * n) = (u32x2){pk_bf16(hv[0], hv[1]), pk_bf16(hv[2], hv[3])};
                }
            }
            asm volatile("" ::: "memory"); __builtin_amdgcn_sched_barrier(0);
        }
    }
};
struct EpiConvGate4 {
    static constexpr bool PERM = true, AFTER_DRAIN = false, NEEDS_ALIGN = true, APERM4 = true;
    bf16_t* H; int ldh; const float* cw; const float* cb; float* halo; PG8_LAS unsigned char* tail; int N_, FF_; PG8_LAS float* wl; StaticOrder So; mutable int ui_;
    __device__ __forceinline__ void operator()(const f32x4 (&acc)[2][2][4][2], const Unit& u, int wr, int wc, int fr, int fq) const {
        const int cwl = wc * 32 + 8 * fq;
        PG8_LAS float* T = (PG8_LAS float*)tail;
        const int hc = u.pn * 128 + cwl, rowb = u.pm * BM + wr * 64 + 4 * fr;
        const int wrow = wr * 4 + wc, wc2 = fq * 16 + fr;
        const float wsc = (wrow < 3 || wrow == 6) ? -1.4426950408889634f : -0.6931471805599453f;
        const float* wsrc0 = (wrow < 6) ? cw + (size_t)(wrow % 3) * N_ + (wrow / 3) * FF_ + 2 * wc2 : cb + (wrow - 6) * FF_ + 2 * wc2;
        PG8_LAS float* wlc = wl + (ui_ & 1) * 1024;
        if (ui_ == 0) { const f32x2 v = *(const f32x2*)(wsrc0 + u.pn * 128); *(PG8_LAS f32x2*)(wlc + wrow * 128 + 2 * wc2) = v * wsc; }
        if (fr == 15) {
#pragma unroll
            for (int ai = 0; ai < 2; ++ai)
#pragma unroll
                for (int bj = 0; bj < 2; ++bj)
#pragma unroll
                    for (int n = 0; n < 2; ++n) { *(PG8_LAS f32x4*)(T + (((2 * ai + wr) * 2 + 0) * 256 + 128 * bj + cwl + 4 * n)) = acc[ai][bj][2][n];
                                                  *(PG8_LAS f32x4*)(T + (((2 * ai + wr) * 2 + 1) * 256 + 128 * bj + cwl + 4 * n)) = acc[ai][bj][3][n]; }
        }
        if (wr == 0 && fr == 0) {
#pragma unroll
            for (int bj = 0; bj < 2; ++bj)
#pragma unroll
                for (int n = 0; n < 2; ++n) { *(f32x4*)(halo + ((size_t)(u.pm * 4 + 0)) * N_ + u.pn * 256 + 128 * bj + cwl + 4 * n) = acc[0][bj][0][n];
                                              *(f32x4*)(halo + ((size_t)(u.pm * 4 + 1)) * N_ + u.pn * 256 + 128 * bj + cwl + 4 * n) = acc[0][bj][1][n]; }
        }
        if (wr == 1 && fr == 15) {
#pragma unroll
            for (int bj = 0; bj < 2; ++bj)
#pragma unroll
                for (int n = 0; n < 2; ++n) { *(f32x4*)(halo + ((size_t)(u.pm * 4 + 2)) * N_ + u.pn * 256 + 128 * bj + cwl + 4 * n) = acc[1][bj][2][n];
                                              *(f32x4*)(halo + ((size_t)(u.pm * 4 + 3)) * N_ + u.pn * 256 + 128 * bj + cwl + 4 * n) = acc[1][bj][3][n]; }
        }
        asm volatile("s_waitcnt lgkmcnt(0)" ::: "memory"); __builtin_amdgcn_s_barrier(); asm volatile("" ::: "memory");
        Unit nxu; const bool has_nx = So.next(ui_ + 1, nxu);
        f32x2 wnext = {0.f, 0.f}; if (has_nx) wnext = *(const f32x2*)(wsrc0 + nxu.pn * 128);
#pragma unroll
        for (int n = 0; n < 2; ++n) {
            f32x4 w[2][3], bb[2];
#pragma unroll
            for (int bj = 0; bj < 2; ++bj) {
#pragma unroll
                for (int t = 0; t < 3; ++t) w[bj][t] = *(const PG8_LAS f32x4*)(wlc + (3 * bj + t) * 128 + cwl + 4 * n);
                bb[bj] = *(const PG8_LAS f32x4*)(wlc + (6 + bj) * 128 + cwl + 4 * n); }
#pragma unroll
            for (int ai = 0; ai < 2; ++ai) {
                f32x4 zc[4][2];
#pragma unroll
                for (int bj = 0; bj < 2; ++bj) {
                    f32x4 t15 = (f32x4){0.f, 0.f, 0.f, 0.f}, t14 = (f32x4){0.f, 0.f, 0.f, 0.f};
                    if (!(ai == 0 && wr == 0) && fr == 0) { const int pb = 2 * ai + wr - 1;
                        t15 = *(const PG8_LAS f32x4*)(T + ((pb * 2 + 1) * 256 + 128 * bj + cwl + 4 * n)); t14 = *(const PG8_LAS f32x4*)(T + ((pb * 2 + 0) * 256 + 128 * bj + cwl + 4 * n)); }
                    const f32x4 z0 = acc[ai][bj][0][n], z1 = acc[ai][bj][1][n], z2 = acc[ai][bj][2][n], z3 = acc[ai][bj][3][n];
                    f32x4 v0 = bb[bj] + w[bj][2] * z0 + w[bj][1] * t15 + w[bj][0] * t14;
                    f32x4 v1 = bb[bj] + w[bj][2] * z1 + w[bj][1] * z0 + w[bj][0] * t15;
                    const f32x4 v2 = bb[bj] + w[bj][2] * z2 + w[bj][1] * z1 + w[bj][0] * z0;
                    const f32x4 v3 = bb[bj] + w[bj][2] * z3 + w[bj][1] * z2 + w[bj][0] * z1;
#pragma unroll
                    for (int e = 0; e < 4; ++e) {
                        float x0 = v0[e], x1 = v1[e];
                        asm("v_fmac_f32_dpp %0, %1, %2 row_shr:1 row_mask:0xf bank_mask:0xf bound_ctrl:1" : "+v"(x0) : "v"(z3[e]), "v"(w[bj][1][e]));
                        asm("v_fmac_f32_dpp %0, %1, %2 row_shr:1 row_mask:0xf bank_mask:0xf bound_ctrl:1" : "+v"(x0) : "v"(z2[e]), "v"(w[bj][0][e]));
                        asm("v_fmac_f32_dpp %0, %1, %2 row_shr:1 row_mask:0xf bank_mask:0xf bound_ctrl:1" : "+v"(x1) : "v"(z3[e]), "v"(w[bj][0][e]));
                        v0[e] = x0; v1[e] = x1; }
                    zc[0][bj] = v0; zc[1][bj] = v1; zc[2][bj] = v2; zc[3][bj] = v3; }
#pragma unroll
                for (int m = 0; m < 4; ++m) {
                    float hv[4];
#pragma unroll
                    for (int e = 0; e < 4; ++e) { const float g = zc[m][0][e]; hv[e] = g * __builtin_amdgcn_rcpf(1.0f + __builtin_amdgcn_exp2f(g)) * zc[m][1][e]; }
                    typedef unsigned u32x2 __attribute__((ext_vector_type(2)));
                    *(u32x2*)(H + (size_t)(rowb + ai * HALF + m) * ldh + hc + 4 * n) = (u32x2){pk_bf16(hv[0], hv[1]), pk_bf16(hv[2], hv[3])};
                }
            }
            asm volatile("" ::: "memory"); __builtin_amdgcn_sched_barrier(0);
        }
        if (has_nx) *(PG8_LAS f32x2*)(wl + ((ui_ + 1) & 1) * 1024 + wrow * 128 + 2 * wc2) = wnext * wsc;
        ++ui_;
    }
};
struct EpiPlainKS {
    static constexpr bool PERM = true, AFTER_DRAIN = false, NEEDS_ALIGN = false, KSCALE = true;
    bf16_t* O; int ldc; const PG8_LAS float* tab;
    __device__ __forceinline__ void kscale(f32x4 (&acc)[2][2][4][2], int ui, int kb, int wr, int fr) const {
#pragma unroll
        for (int ai = 0; ai < 2; ++ai)
#pragma unroll
            for (int m = 0; m < 4; ++m) { const float s = tab[((ui & 1) * 256 + ai * HALF + wr * 64 + m * 16 + fr) * 8 + kb];
#pragma unroll
                for (int bj = 0; bj < 2; ++bj)
#pragma unroll
                    for (int n = 0; n < 2; ++n) acc[ai][bj][m][n] = acc[ai][bj][m][n] * s; }
    }
    __device__ __forceinline__ void operator()(const f32x4 (&acc)[2][2][4][2], const Unit& u, int wr, int wc, int fr, int fq) const {
        const int row0 = u.pm * BM + wr * 64 + fr, col0 = u.pn * BM + wc * 32 + 8 * fq;
#pragma unroll
        for (int ai = 0; ai < 2; ++ai)
#pragma unroll
            for (int m = 0; m < 4; ++m) { bf16_t* rowp = O + (size_t)(row0 + ai * HALF + m * 16) * ldc + col0;
#pragma unroll
                for (int bj = 0; bj < 2; ++bj) { const f32x4 v0 = acc[ai][bj][m][0], v1 = acc[ai][bj][m][1];
                    u32x4 w; w.x = pk_bf16(v0[0], v0[1]); w.y = pk_bf16(v0[2], v0[3]); w.z = pk_bf16(v1[0], v1[1]); w.w = pk_bf16(v1[2], v1[3]);
                    *(u32x4*)(rowp + bj * HALF) = w; } }
    }
};
struct EpiNull {
    static constexpr bool PERM = true, AFTER_DRAIN = false, NEEDS_ALIGN = false;
    __device__ __forceinline__ void operator()(const f32x4 (&acc)[2][2][4][2], const Unit& u, int wr, int wc, int fr, int fq) const {
#pragma unroll
        for (int ai = 0; ai < 2; ++ai)
#pragma unroll
            for (int bj = 0; bj < 2; ++bj)
#pragma unroll
                for (int m = 0; m < 4; ++m)
#pragma unroll
                    for (int n = 0; n < 2; ++n) asm volatile("" :: "v"(acc[ai][bj][m][n]));
    }
};
}
constexpr int NWAVES = 8;
constexpr int NB = 4, SEQ = 4096, M = NB * SEQ, D = 2048;
constexpr int GH = 6144, GD = 2 * GH;
constexpr int RPROJ = 12288, RV = 4096;
constexpr int FF = 5632, FF2 = 2 * FF;
constexpr float EPS = 1e-6f;
constexpr size_t MiB = 1u << 20;
constexpr size_t WS_CTL = 0, WS_STATS = 1 * MiB, ZERO_BYTES = 128 * 1024;
constexpr size_t WS_WA = 2 * MiB;
constexpr size_t WS_WB = 50 * MiB;
constexpr size_t WS_HN = 74 * MiB;
constexpr size_t WS_BIG = 138 * MiB;
constexpr size_t WS_H2 = 522 * MiB;
constexpr size_t WS_END = 698 * MiB;
constexpr size_t ST_S1 = 0, ST_S2 = (size_t)M * 4, ST_SS = (size_t)M * 8;
static_assert(ST_SS + (size_t)8 * M * 4 <= MiB, "stats region");
static_assert((size_t)M * RV * 2 + (size_t)128 * M * 4 <= WS_END - WS_H2, "retention output + partial sums of squares fit in H2");
constexpr int CW_TMO = 0, CW_CODE = 1, CW_BAR = 4096, CW_DBG = 16384;
constexpr int RING_BYTES = 131072, LDSCTL_OFF = RING_BYTES, MISC_OFF = LDSCTL_OFF + 320, LDS_BYTES = 163840, TAIL_OFF = 132096, RTAB_OFF = 140288;
static_assert(TAIL_OFF >= MISC_OFF + 128 && TAIL_OFF + 8192 <= RTAB_OFF && RTAB_OFF + 16384 <= LDS_BYTES, "LDS map");
#define GAS __attribute__((address_space(1)))
#define LAS __attribute__((address_space(3)))
typedef unsigned short bf16;
typedef unsigned v4u __attribute__((ext_vector_type(4)));
typedef float f32x4 __attribute__((ext_vector_type(4)));
typedef short bf16x8 __attribute__((ext_vector_type(8)));
typedef GAS unsigned gu32;
typedef GAS unsigned long long gu64;
#define RLX_AGENT __ATOMIC_RELAXED, __HIP_MEMORY_SCOPE_AGENT
#define LDS_WAIT() asm volatile("s_waitcnt lgkmcnt(0)" ::: "memory")
#define VM_WAIT() asm volatile("s_waitcnt vmcnt(0)" ::: "memory")
__device__ __forceinline__ unsigned long long rt() { return __builtin_amdgcn_s_memrealtime(); }
__device__ __forceinline__ unsigned f2bf(float f) { unsigned u = __builtin_bit_cast(unsigned, f); return (u + 0x7fffu + ((u >> 16) & 1u)) >> 16; }
__device__ __forceinline__ unsigned pk2(float lo, float hi) { return f2bf(lo) | (f2bf(hi) << 16); }

#define XB_TMO      128
#define XB_XCNT(j)  (256  + 64 * (j))
#define XB_XSUB(j)  (1280 + 64 * (j))
#define XB_XGEN(j)  (2304 + 64 * (j))
#define XB_TOP      3328
#define XB_TOPGEN   3392
#define XCD_BAR_WORDS 3456
#define XB_SPIN_CAP (1u << 18)

__device__ __forceinline__ unsigned xb_ld(unsigned* p)              { return __hip_atomic_load(p, __ATOMIC_RELAXED, __HIP_MEMORY_SCOPE_AGENT); }
__device__ __forceinline__ unsigned xb_add(unsigned* p, unsigned v) { return __hip_atomic_fetch_add(p, v, __ATOMIC_RELAXED, __HIP_MEMORY_SCOPE_AGENT); }
__device__ __forceinline__ unsigned xb_xcc_id() { return (unsigned)__builtin_amdgcn_s_getreg((3 << 11) | 20) & 0xFu; }
#define XB_SPIN(cond, bar) do { unsigned _sp = 0; while (cond) { __builtin_amdgcn_s_sleep(1); \
    if ((++_sp & 255u) == 0u) { if (xb_ld(&(bar)[XB_TMO])) break; if (_sp > XB_SPIN_CAP) { atomicAdd(&(bar)[XB_TMO], 1u); break; } } } } while (0)

struct XcdBarrier {
    unsigned* bar; unsigned x;
    volatile LAS unsigned* st;
};

__device__ __forceinline__ XcdBarrier xcd_barrier_post(unsigned* bar, volatile LAS unsigned* st) {
    XcdBarrier b; b.bar = bar; b.x = xb_xcc_id(); b.st = st;
    if (threadIdx.x == 0) (void)xb_add(&bar[XB_XCNT(b.x)], 1u);
    return b;
}
__device__ __forceinline__ void xcd_barrier_complete(unsigned* bar, unsigned x, unsigned& nloc, unsigned& nx) {
    const unsigned G = gridDim.x * gridDim.y * gridDim.z;
    unsigned sum, cnt, mine, sp = 0u;
    for (;;) {
        sum = 0u; cnt = 0u; mine = 0u;
#pragma unroll
        for (unsigned j = 0; j < 16; ++j) { const unsigned c = xb_ld(&bar[XB_XCNT(j)]); sum += c; cnt += (c > 0u) ? 1u : 0u; mine = (j == x) ? c : mine; }
        if (sum == G) break;
        __builtin_amdgcn_s_sleep(1);
        if ((++sp & 255u) == 0u) { if (xb_ld(&bar[XB_TMO])) break; if (sp > XB_SPIN_CAP) { atomicAdd(&bar[XB_TMO], 1u); break; } }
    }
    nloc = mine > 0u ? mine : 1u; nx = cnt > 0u ? cnt : 1u;
}

__device__ __forceinline__ void xcd_barrier(const XcdBarrier& b) {
    asm volatile("s_waitcnt vmcnt(0)" ::: "memory");
    __syncthreads();
    if (threadIdx.x == 0) {
        unsigned* bar = b.bar;
        __builtin_amdgcn_s_waitcnt(0);
        unsigned nloc = b.st[0], nx = b.st[1];
        if (nloc == 0u) { xcd_barrier_complete(bar, b.x, nloc, nx); b.st[0] = nloc; b.st[1] = nx; }
        const unsigned old = xb_add(&bar[XB_XSUB(b.x)], 1u);
        const unsigned gen = old / nloc;
        if (old + 1u == (gen + 1u) * nloc) {
            __builtin_amdgcn_fence(__ATOMIC_RELEASE, "agent");
            asm volatile("s_waitcnt vmcnt(0)" ::: "memory");
            const unsigned og = xb_add(&bar[XB_TOP], 1u);
            const unsigned tg = og / nx;
            if (og + 1u == (tg + 1u) * nx) xb_add(&bar[XB_TOPGEN], 1u);
            else XB_SPIN(xb_ld(&bar[XB_TOPGEN]) == tg, bar);
            __builtin_amdgcn_fence(__ATOMIC_ACQUIRE, "agent");
            xb_add(&bar[XB_XGEN(b.x)], 1u);
            asm volatile("s_waitcnt vmcnt(0)" ::: "memory");
        } else {
            XB_SPIN(xb_ld(&bar[XB_XGEN(b.x)]) == gen, bar);
            __builtin_amdgcn_fence(__ATOMIC_ACQUIRE, "agent");
            asm volatile("s_waitcnt vmcnt(0)" ::: "memory");
        }
    }
    __syncthreads();
}
template <int CTRL> __device__ __forceinline__ float dppf(float v) { return __builtin_bit_cast(float, __builtin_amdgcn_mov_dpp(__builtin_bit_cast(int, v), CTRL, 0xF, 0xF, true)); }
__device__ __forceinline__ float wave_sum(float v) {
    v += dppf<0xB1>(v); v += dppf<0x4E>(v); v += dppf<0x141>(v); v += dppf<0x140>(v);
    v += __builtin_bit_cast(float, __builtin_amdgcn_ds_swizzle(__builtin_bit_cast(int, v), 0x401F));
    return __builtin_bit_cast(float, __builtin_amdgcn_readlane(__builtin_bit_cast(int, v), 0)) + __builtin_bit_cast(float, __builtin_amdgcn_readlane(__builtin_bit_cast(int, v), 32));
}
#ifdef CVT_NT_LOADS
#define CVT_LD(p) __builtin_nontemporal_load(p)
#else
#define CVT_LD(p) (*(p))
#endif
template <bool ILV = false, bool GAIN = false, int CVD = 0> __device__ __forceinline__ void cvt_items(const float* W, int K, int N, bf16* WT, LAS float* scr, int it0, int it_end, int stride, int lane, const float* gk = nullptr) {
    const int nblk = N / 32;
    float v[32];
#define CV_LOAD(it_) do { const int kb_ = (it_) / nblk, nb_ = (it_) % nblk; const float* p_ = W + (size_t)(64 * kb_ + (lane >> 5)) * N + 32 * nb_ + (lane & 31); \
        const float* pc_ = W + (size_t)(it_) * 2048 + lane;     \
        _Pragma("unroll") for (int i = 0; i < 32; ++i) { if (CVD == 2) v[i] = (float)(i + (it_)); else if (CVD == 4) v[i] = CVT_LD(pc_ + 64 * i); else v[i] = CVT_LD(p_ + (size_t)(2 * i) * N); } } while (0)
    if (it0 < it_end) CV_LOAD(it0);
    for (int item = it0; item < it_end; item += stride) {
        const int kb = item / nblk, nb = item % nblk, k0 = 64 * kb, n0 = 32 * nb;
        if (CVD != 3) {
#pragma unroll
            for (int i = 0; i < 32; ++i) scr[(2 * i + (lane >> 5)) * 33 + (lane & 31)] = v[i]; }
        float keep[32];
        if (CVD == 3) {
#pragma unroll
            for (int i = 0; i < 32; ++i) keep[i] = v[i]; }
        if (item + stride < it_end) CV_LOAD(item + stride);
        LDS_WAIT(); asm volatile("" ::: "memory");
        const int c = lane & 7;
        float gv[8];
        if (GAIN) { const f32x4 ga = *(const GAS f32x4*)(gk + k0 + 8 * c), gb = *(const GAS f32x4*)(gk + k0 + 8 * c + 4); gv[0] = ga.x; gv[1] = ga.y; gv[2] = ga.z; gv[3] = ga.w; gv[4] = gb.x; gv[5] = gb.y; gv[6] = gb.z; gv[7] = gb.w; }
#pragma unroll
        for (int j = 0; j < 4; ++j) { const int n = (lane >> 3) + 8 * j; const LAS float* s = scr + (8 * c) * 33 + n;
            v4u o;
            if (CVD == 3) { o.x = pk2(keep[8 * j], keep[8 * j + 1]); o.y = pk2(keep[8 * j + 2], keep[8 * j + 3]); o.z = pk2(keep[8 * j + 4], keep[8 * j + 5]); o.w = pk2(keep[8 * j + 6], keep[8 * j + 7]); }
            else if (GAIN) { o.x = pk2(s[0 * 33] * gv[0], s[1 * 33] * gv[1]); o.y = pk2(s[2 * 33] * gv[2], s[3 * 33] * gv[3]); o.z = pk2(s[4 * 33] * gv[4], s[5 * 33] * gv[5]); o.w = pk2(s[6 * 33] * gv[6], s[7 * 33] * gv[7]); }
            else { o.x = pk2(s[0 * 33], s[1 * 33]); o.y = pk2(s[2 * 33], s[3 * 33]); o.z = pk2(s[4 * 33], s[5 * 33]); o.w = pk2(s[6 * 33], s[7 * 33]); }
            const int nr = ILV ? ((n0 < N / 2) ? (n0 >> 7) * 256 + (n0 & 127) : (((n0 - N / 2) >> 7) * 256 + 128 + ((n0 - N / 2) & 127))) : n0;
            if (CVD == 1) asm volatile("" :: "v"(o)); else *(GAS v4u*)(WT + (size_t)(nr + n) * K + k0 + 8 * c) = o; }
        LDS_WAIT(); asm volatile("" ::: "memory");
    }
#undef CV_LOAD
}

template <bool ILV = false, bool GAIN = false> __device__ __forceinline__ void cvt_blocks(const float* W, int K, int N, bf16* WT, LAS unsigned char* lds, int b0, int b_end, int bstride, int tid, const float* gk = nullptr) {
    constexpr int PITCH = 257;
    const int w = tid >> 6, l = tid & 63, nbk = N / 256;
    f32x4 v[8];
#define CB_LOAD(bi_) do { const int kb_ = (bi_) / nbk, nb_ = (bi_) % nbk; const float* p_ = W + (size_t)(64 * kb_ + 8 * w) * N + 256 * nb_ + 4 * l; \
        _Pragma("unroll") for (int r = 0; r < 8; ++r) v[r] = CVT_LD((const GAS f32x4*)(p_ + (size_t)r * N)); } while (0)
    if (b0 < b_end) CB_LOAD(b0);
    int buf = 0;
    for (int bi = b0; bi < b_end; bi += bstride, buf ^= 1) {
        const int kb = bi / nbk, nb = bi % nbk, k0 = 64 * kb, n0 = 256 * nb;
        LAS unsigned* T = (LAS unsigned*)(lds + buf * 36864);
        if (GAIN) {
#pragma unroll
            for (int r = 0; r < 8; ++r) v[r] = v[r] * gk[k0 + 8 * w + r]; }
#pragma unroll
        for (int p = 0; p < 4; ++p) { v4u d; d.x = pk2(v[2 * p].x, v[2 * p + 1].x); d.y = pk2(v[2 * p].y, v[2 * p + 1].y); d.z = pk2(v[2 * p].z, v[2 * p + 1].z); d.w = pk2(v[2 * p].w, v[2 * p + 1].w);
            LAS unsigned* q = T + (4 * w + p) * PITCH + 4 * l; q[0] = d.x; q[1] = d.y; q[2] = d.z; q[3] = d.w; }
        if (bi + bstride < b_end) CB_LOAD(bi + bstride);
        LDS_WAIT(); __builtin_amdgcn_s_barrier(); asm volatile("" ::: "memory");
        const int c = l & 7;
#pragma unroll
        for (int j = 0; j < 4; ++j) { const int n = 32 * w + (l >> 3) + 8 * j; const LAS unsigned* q = T + (4 * c) * PITCH + n;
            v4u o; o.x = q[0]; o.y = q[PITCH]; o.z = q[2 * PITCH]; o.w = q[3 * PITCH];
            const int col = n0 + n;
            const int nr = ILV ? ((col < N / 2) ? (col >> 7) * 256 + (col & 127) : (((col - N / 2) >> 7) * 256 + 128 + ((col - N / 2) & 127))) : col;
            *(GAS v4u*)(WT + (size_t)nr * K + k0 + 8 * c) = o; }
    }
    LDS_WAIT(); __builtin_amdgcn_s_barrier(); asm volatile("" ::: "memory");
#undef CB_LOAD
}
typedef float f32x16 __attribute__((ext_vector_type(16)));
typedef short s16x4 __attribute__((ext_vector_type(4)));
typedef unsigned v2u __attribute__((ext_vector_type(2)));
typedef float f32x2_t __attribute__((ext_vector_type(2))); typedef __bf16 bf16x2_t __attribute__((ext_vector_type(2)));
__device__ __forceinline__ unsigned pkbf(float lo, float hi) { f32x2_t v = {lo, hi}; bf16x2_t b = __builtin_convertvector(v, bf16x2_t); return __builtin_bit_cast(unsigned, b); }
__device__ __forceinline__ float bflo(unsigned w) { return __builtin_bit_cast(float, w << 16); }
__device__ __forceinline__ float bfhi(unsigned w) { return __builtin_bit_cast(float, w & 0xffff0000u); }
__device__ __forceinline__ void unpack8(const v4u& w, float (&f)[8]) { f[0] = bflo(w.x); f[1] = bfhi(w.x); f[2] = bflo(w.y); f[3] = bfhi(w.y); f[4] = bflo(w.z); f[5] = bfhi(w.z); f[6] = bflo(w.w); f[7] = bfhi(w.w); }
__device__ __forceinline__ v4u pack8(const float (&f)[8]) { v4u w; w.x = pkbf(f[0], f[1]); w.y = pkbf(f[2], f[3]); w.z = pkbf(f[4], f[5]); w.w = pkbf(f[6], f[7]); return w; }
__device__ __forceinline__ s16x4 tr_rd(LAS const unsigned char* p) { typedef short v4i16_t __attribute__((ext_vector_type(4))); return __builtin_bit_cast(s16x4, __builtin_amdgcn_ds_read_tr16_b64_v4i16((LAS v4i16_t*)p)); }
__device__ __forceinline__ bf16x8 cat8(s16x4 lo, s16x4 hi) { return __builtin_shufflevector(lo, hi, 0, 1, 2, 3, 4, 5, 6, 7); }
#define MFMA32(a, b, c) __builtin_amdgcn_mfma_f32_32x32x16_bf16((a), (b), (c), 0, 0, 0)
__device__ __forceinline__ f32x16 zero16() { f32x16 z;
#pragma unroll
    for (int i = 0; i < 16; ++i) z[i] = 0.f; return z; }
__device__ __forceinline__ float silu_f(float x) { return x * __builtin_amdgcn_rcpf(1.0f + __builtin_amdgcn_exp2f(-1.4426950408889634f * x)); }

__device__ __forceinline__ size_t blk_off(int row, int col, int KT) { return ((size_t)(row >> 8) * KT + (col >> 6)) * 16384 + ((row & 255) << 6) + (col & 63); }
template <bool ILV = false, int CVD = 0> __device__ __forceinline__ void convert_weight(const float* W, int K, int N, bf16* WT, LAS unsigned char* lds, int gw, int NGW, int wave, int lane) {
    LAS float* scr = (LAS float*)(lds + wave * 16384);
    const int nblk = N / 32, nitems = (K / 64) * nblk;
    cvt_items<ILV, false, CVD>(W, K, N, WT, scr, gw, nitems, NGW, lane);
}

template <bool ILV = false, bool GAIN = false> __device__ __forceinline__ void convert_weight_grp(const float* W, int K, int N, bf16* WT, LAS unsigned char* lds, int grp, int gwl, int NGWL, int wave, int lane, const float* gk = nullptr) {
    LAS float* scr = (LAS float*)(lds + wave * 16384);
    const int nblk = N / 32, nitems = (K / 64) * nblk, h0 = nitems / 2, lo = grp ? h0 : 0, hi = grp ? nitems : h0;
    cvt_items<ILV, GAIN>(W, K, N, WT, scr, lo + gwl, hi, NGWL, lane, gk);
}
template <bool ILV = false, bool GAIN = false> __device__ __forceinline__ void convert_weight_stag(const float* W, int K, int N, bf16* WT, LAS unsigned char* lds, int bx, int G, int wave, int lane, int part, const float* gk = nullptr) {
    LAS float* scr = (LAS float*)(lds + wave * 16384);
    const int grp = bx & 3, gwl = (bx >> 2) * NWAVES + wave, NGWL = ((G + 3 - grp) >> 2) * NWAVES;
    const int nblk = N / 32, nitems = (K / 64) * nblk, q = nitems / 4, lo = grp * q, hi = (grp == 3) ? nitems : lo + q;
    const int first = lo + gwl, nj = (first < hi) ? (hi - first + NGWL - 1) / NGWL : 0, npre = (nj * grp + 1) / 3;
    const int j0 = part ? npre : 0, j1 = part ? nj : npre;
    if (j1 > j0) { const int e_ = first + j1 * NGWL; cvt_items<ILV, GAIN>(W, K, N, WT, scr, first + j0 * NGWL, e_ < hi ? e_ : hi, NGWL, lane, gk); }
}
template <bool ILV = false, bool GAIN = false> __device__ __forceinline__ void convert_weight_stagb(const float* W, int K, int N, bf16* WT, LAS unsigned char* lds, int bx, int G, int tid, int part, const float* gk = nullptr) {
    const int grp = bx & 3, wgi = bx >> 2, NW = (G + 3 - grp) >> 2;
    const int nb = (K / 64) * (N / 256), q = nb / 4, lo = grp * q, hi = (grp == 3) ? nb : lo + q;
    const int first = lo + wgi, nj = (first < hi) ? (hi - first + NW - 1) / NW : 0, npre = (nj * grp + 1) / 3;
    const int j0 = part ? npre : 0, j1 = part ? nj : npre;
    if (j1 > j0) { const int e_ = first + j1 * NW; cvt_blocks<ILV, GAIN>(W, K, N, WT, lds, first + j0 * NW, e_ < hi ? e_ : hi, NW, tid, gk); }
}
#ifdef X_NT_LOADS
#define X_LD(p) __builtin_nontemporal_load(p)
#else
#define X_LD(p) (*(p))
#endif
__device__ __forceinline__ void first_norm_phase(int gw, int NGW, int lane, const float* x, const float* g, bf16* hn) {
    float gg[4][8];
#pragma unroll
    for (int j = 0; j < 4; ++j) { const f32x4 a = ((const GAS f32x4*)g)[2 * (lane + 64 * j)], b = ((const GAS f32x4*)g)[2 * (lane + 64 * j) + 1]; gg[j][0] = a.x; gg[j][1] = a.y; gg[j][2] = a.z; gg[j][3] = a.w; gg[j][4] = b.x; gg[j][5] = b.y; gg[j][6] = b.z; gg[j][7] = b.w; }
    for (int m = gw; m < M; m += NGW) {
        const GAS f32x4* xr = (const GAS f32x4*)(x + (size_t)m * D);
        float xv[4][8]; float ss = 0.f;
#pragma unroll
        for (int j = 0; j < 4; ++j) { const f32x4 a = X_LD(xr + 2 * (lane + 64 * j)), b = X_LD(xr + 2 * (lane + 64 * j) + 1); xv[j][0] = a.x; xv[j][1] = a.y; xv[j][2] = a.z; xv[j][3] = a.w; xv[j][4] = b.x; xv[j][5] = b.y; xv[j][6] = b.z; xv[j][7] = b.w;
#pragma unroll
            for (int i = 0; i < 8; ++i) ss += xv[j][i] * xv[j][i]; }
        const float r = rsqrtf(wave_sum(ss) * (1.0f / D) + EPS);
#pragma unroll
        for (int j = 0; j < 4; ++j) { float t[8];
#pragma unroll
            for (int i = 0; i < 8; ++i) t[i] = xv[j][i] * r * gg[j][i];
            *(GAS v4u*)(hn + (size_t)m * D + 8 * (lane + 64 * j)) = pack8(t); }
    }
}
template <bool NEXT>
__device__ __forceinline__ void resid_norm_phase(int gw, int NGW, int lane, const bf16* Y, const float* xin, float* xout, const float* gpost, const float* gnext, bf16* hn) {
    float gp[4][8], gn[4][8];
#pragma unroll
    for (int j = 0; j < 4; ++j) { const f32x4 a = ((const GAS f32x4*)gpost)[2 * (lane + 64 * j)], b = ((const GAS f32x4*)gpost)[2 * (lane + 64 * j) + 1]; gp[j][0] = a.x; gp[j][1] = a.y; gp[j][2] = a.z; gp[j][3] = a.w; gp[j][4] = b.x; gp[j][5] = b.y; gp[j][6] = b.z; gp[j][7] = b.w;
        if (NEXT) { const f32x4 c = ((const GAS f32x4*)gnext)[2 * (lane + 64 * j)], d = ((const GAS f32x4*)gnext)[2 * (lane + 64 * j) + 1]; gn[j][0] = c.x; gn[j][1] = c.y; gn[j][2] = c.z; gn[j][3] = c.w; gn[j][4] = d.x; gn[j][5] = d.y; gn[j][6] = d.z; gn[j][7] = d.w; } }
    for (int m = gw; m < M; m += NGW) {
        const GAS v4u* yr = (const GAS v4u*)(Y + (size_t)m * D);
        const GAS f32x4* xr = (const GAS f32x4*)(xin + (size_t)m * D);
        GAS f32x4* xo = (GAS f32x4*)(xout + (size_t)m * D);
        float yv[4][8], xv[4][8]; float ss = 0.f;
#pragma unroll
        for (int j = 0; j < 4; ++j) { const v4u w = yr[lane + 64 * j]; unpack8(w, yv[j]);
            const f32x4 a = xr[2 * (lane + 64 * j)], b = xr[2 * (lane + 64 * j) + 1]; xv[j][0] = a.x; xv[j][1] = a.y; xv[j][2] = a.z; xv[j][3] = a.w; xv[j][4] = b.x; xv[j][5] = b.y; xv[j][6] = b.z; xv[j][7] = b.w;
#pragma unroll
            for (int i = 0; i < 8; ++i) ss += yv[j][i] * yv[j][i]; }
        const float r1 = rsqrtf(wave_sum(ss) * (1.0f / D) + EPS); float s2 = 0.f;
#pragma unroll
        for (int j = 0; j < 4; ++j) {
#pragma unroll
            for (int i = 0; i < 8; ++i) { xv[j][i] += yv[j][i] * r1 * gp[j][i]; s2 += xv[j][i] * xv[j][i]; }
            xo[2 * (lane + 64 * j)] = (f32x4){xv[j][0], xv[j][1], xv[j][2], xv[j][3]}; xo[2 * (lane + 64 * j) + 1] = (f32x4){xv[j][4], xv[j][5], xv[j][6], xv[j][7]}; }
        if (NEXT) { const float r2 = rsqrtf(wave_sum(s2) * (1.0f / D) + EPS);
#pragma unroll
            for (int j = 0; j < 4; ++j) { float t[8];
#pragma unroll
                for (int i = 0; i < 8; ++i) t[i] = xv[j][i] * r2 * gn[j][i];
                *(GAS v4u*)(hn + (size_t)m * D + 8 * (lane + 64 * j)) = pack8(t); } }
    }
}
template <bool XF32, bool LAST, bool PF = true>
__device__ __forceinline__ void resid_fold_phase(int gw, int NGW, int lane, const bf16* Y, const void* xin, const float* rin, void* xout, float* rout, const float* gpost) {
    float gp[4][8];
#pragma unroll
    for (int j = 0; j < 4; ++j) { const f32x4 a = ((const GAS f32x4*)gpost)[2 * (lane + 64 * j)], b = ((const GAS f32x4*)gpost)[2 * (lane + 64 * j) + 1]; gp[j][0] = a.x; gp[j][1] = a.y; gp[j][2] = a.z; gp[j][3] = a.w; gp[j][4] = b.x; gp[j][5] = b.y; gp[j][6] = b.z; gp[j][7] = b.w; }
    v4u yw[4], xw[XF32 ? 8 : 4]; float riw = 1.0f;
    int lz = 0; asm volatile("" : "+v"(lz));
#define RF_LOAD(m_) do { const GAS v4u* yr_ = (const GAS v4u*)(Y + (size_t)(m_) * D); \
        _Pragma("unroll") for (int j = 0; j < 4; ++j) yw[j] = yr_[lane + 64 * j]; \
        if (XF32) { const GAS v4u* xr_ = (const GAS v4u*)((const float*)xin + (size_t)(m_) * D); _Pragma("unroll") for (int j = 0; j < 4; ++j) { xw[2 * j] = X_LD(xr_ + 2 * (lane + 64 * j)); xw[2 * j + 1] = X_LD(xr_ + 2 * (lane + 64 * j) + 1); } } \
        else { const GAS v4u* xr_ = (const GAS v4u*)((const bf16*)xin + (size_t)(m_) * D); _Pragma("unroll") for (int j = 0; j < 4; ++j) xw[j] = xr_[lane + 64 * j]; riw = ((const GAS float*)rin)[(m_) + lz]; } } while (0)
    if (PF && gw < M) RF_LOAD(gw);
    for (int m = gw; m < M; m += NGW) {
        float yv[4][8], xv[4][8]; float ss = 0.f;
        if (!PF) RF_LOAD(m);
        const float ri = riw;
#pragma unroll
        for (int j = 0; j < 4; ++j) { unpack8(yw[j], yv[j]);
            if (XF32) { const f32x4 a = __builtin_bit_cast(f32x4, xw[2 * j]), b = __builtin_bit_cast(f32x4, xw[2 * j + 1]);
                xv[j][0] = a.x; xv[j][1] = a.y; xv[j][2] = a.z; xv[j][3] = a.w; xv[j][4] = b.x; xv[j][5] = b.y; xv[j][6] = b.z; xv[j][7] = b.w; }
            else unpack8(xw[XF32 ? 2 * j : j], xv[j]);
#pragma unroll
            for (int i = 0; i < 8; ++i) ss += yv[j][i] * yv[j][i]; }
        if (PF && m + NGW < M) RF_LOAD(m + NGW);
        const float r1 = rsqrtf(wave_sum(ss) * (1.0f / D) + EPS); float s2 = 0.f;
#pragma unroll
        for (int j = 0; j < 4; ++j) {
#pragma unroll
            for (int i = 0; i < 8; ++i) { xv[j][i] = (XF32 ? xv[j][i] : xv[j][i] * ri) + yv[j][i] * r1 * gp[j][i]; s2 += xv[j][i] * xv[j][i]; }
            if (LAST) { GAS f32x4* xo = (GAS f32x4*)((float*)xout + (size_t)m * D); xo[2 * (lane + 64 * j)] = (f32x4){xv[j][0], xv[j][1], xv[j][2], xv[j][3]}; xo[2 * (lane + 64 * j) + 1] = (f32x4){xv[j][4], xv[j][5], xv[j][6], xv[j][7]}; } }
        if (!LAST) { const float ms = wave_sum(s2) * (1.0f / D) + EPS, r2 = rsqrtf(ms);
#pragma unroll
            for (int j = 0; j < 4; ++j) { float t[8];
#pragma unroll
                for (int i = 0; i < 8; ++i) t[i] = xv[j][i] * r2;
                *(GAS v4u*)((bf16*)xout + (size_t)m * D + 8 * (lane + 64 * j)) = pack8(t); }
            if (lane == 0) rout[m] = __builtin_sqrtf(ms); }
    }
#undef RF_LOAD
}
__device__ __forceinline__ void conv_gate_phase(int gw, int NGW, int lane, const bf16* Z, bf16* H, const float* cw, const float* cb) {
    constexpr int RB = 32, NRB = M / RB, NCG = FF / 512;
    for (int it = gw; it < NRB * NCG; it += NGW) {
        const int rb = it / NCG, cg = it % NCG, c0 = 8 * (cg * 64 + lane), m0 = rb * RB;
        float wg[3][8], wu[3][8], bg[8], bu[8];
#pragma unroll
        for (int t = 0; t < 3; ++t) { const GAS f32x4* p = (const GAS f32x4*)(cw + (size_t)t * FF2 + c0); const GAS f32x4* q = (const GAS f32x4*)(cw + (size_t)t * FF2 + FF + c0);
            const f32x4 a = p[0], b = p[1], c = q[0], d = q[1]; wg[t][0] = a.x; wg[t][1] = a.y; wg[t][2] = a.z; wg[t][3] = a.w; wg[t][4] = b.x; wg[t][5] = b.y; wg[t][6] = b.z; wg[t][7] = b.w;
            wu[t][0] = c.x; wu[t][1] = c.y; wu[t][2] = c.z; wu[t][3] = c.w; wu[t][4] = d.x; wu[t][5] = d.y; wu[t][6] = d.z; wu[t][7] = d.w; }
        { const GAS f32x4* p = (const GAS f32x4*)(cb + c0); const GAS f32x4* q = (const GAS f32x4*)(cb + FF + c0); const f32x4 a = p[0], b = p[1], c = q[0], d = q[1];
          bg[0] = a.x; bg[1] = a.y; bg[2] = a.z; bg[3] = a.w; bg[4] = b.x; bg[5] = b.y; bg[6] = b.z; bg[7] = b.w; bu[0] = c.x; bu[1] = c.y; bu[2] = c.z; bu[3] = c.w; bu[4] = d.x; bu[5] = d.y; bu[6] = d.z; bu[7] = d.w; }
        float g1[8], g2[8], u1[8], u2[8];
        if ((m0 % SEQ) == 0) {
#pragma unroll
            for (int i = 0; i < 8; ++i) { g1[i] = 0.f; g2[i] = 0.f; u1[i] = 0.f; u2[i] = 0.f; }
        } else {
            const v4u a = *(const GAS v4u*)(Z + (size_t)(m0 - 1) * FF2 + c0), b = *(const GAS v4u*)(Z + (size_t)(m0 - 2) * FF2 + c0);
            const v4u c = *(const GAS v4u*)(Z + (size_t)(m0 - 1) * FF2 + FF + c0), d = *(const GAS v4u*)(Z + (size_t)(m0 - 2) * FF2 + FF + c0);
            unpack8(a, g1); unpack8(b, g2); unpack8(c, u1); unpack8(d, u2);
        }
#pragma unroll 4
        for (int r = 0; r < RB; ++r) { const int m = m0 + r;
            const v4u a = *(const GAS v4u*)(Z + (size_t)m * FF2 + c0), c = *(const GAS v4u*)(Z + (size_t)m * FF2 + FF + c0);
            float zg[8], zu[8], o[8]; unpack8(a, zg); unpack8(c, zu);
#pragma unroll
            for (int i = 0; i < 8; ++i) { const float gt = bg[i] + wg[0][i] * g2[i] + wg[1][i] * g1[i] + wg[2][i] * zg[i]; const float up = bu[i] + wu[0][i] * u2[i] + wu[1][i] * u1[i] + wu[2][i] * zu[i];
                o[i] = silu_f(gt) * up; g2[i] = g1[i]; g1[i] = zg[i]; u2[i] = u1[i]; u1[i] = zu[i]; }
            *(GAS v4u*)(H + (size_t)m * FF + c0) = pack8(o); }
    }
}
__device__ __forceinline__ void ret_norm_phase(int gw, int NGW, int lane, bf16* O, const float* ssp) {
    for (int m = gw; m < M; m += NGW) {
        v4u ow[8];
#pragma unroll
        for (int j = 0; j < 8; ++j) ow[j] = *(const GAS v4u*)(O + (size_t)m * RV + 8 * (lane + 64 * j));
        float v = ssp[(size_t)lane * M + m] + ssp[(size_t)(lane + 64) * M + m];
        v += dppf<0x128>(v);
        v += __builtin_bit_cast(float, __builtin_amdgcn_ds_swizzle(__builtin_bit_cast(int, v), 0x401F));
        v += __builtin_bit_cast(float, __builtin_amdgcn_ds_bpermute((int)(((unsigned)lane ^ 32u) << 2), __builtin_bit_cast(int, v)));
        const float rl = rsqrtf(v * (1.0f / 512.0f) + EPS);
#pragma unroll
        for (int j = 0; j < 8; ++j) { const float r = __builtin_bit_cast(float, __builtin_amdgcn_readlane(__builtin_bit_cast(int, rl), j));
            float ov[8]; unpack8(ow[j], ov);
#pragma unroll
            for (int i = 0; i < 8; ++i) ov[i] *= r;
            *(GAS v4u*)(O + (size_t)m * RV + 8 * (lane + 64 * j)) = pack8(ov); }
    }
}
__device__ __forceinline__ void ln_stats_phase(int gw, int NGW, int lane, const bf16* V, float* mu, float* rstd) {
    for (int m = gw; m < M; m += NGW) {
        const GAS v4u* vr = (const GAS v4u*)(V + (size_t)m * GH); float a1 = 0.f, a2 = 0.f;
#pragma unroll
        for (int j = 0; j < 12; ++j) { float f[8]; const v4u w = vr[lane + 64 * j]; unpack8(w, f);
#pragma unroll
            for (int i = 0; i < 8; ++i) { a1 += f[i]; a2 += f[i] * f[i]; } }
        const float mean = wave_sum(a1) * (1.0f / GH), var = wave_sum(a2) * (1.0f / GH) - mean * mean;
        if (lane == 0) { mu[m] = mean; rstd[m] = rsqrtf(fmaxf(var, 0.f) + EPS); }
    }
}
__device__ __forceinline__ void ffn_fixup_phase(int gtid, int NT, const float* halo, bf16* H, const float* cw, const float* cb) {
    constexpr int NCH = FF / 8, NIT = (M / 256) * 2 * NCH;
    for (int it = gtid; it < NIT; it += NT) {
        const int ch = it % NCH, r = (it / NCH) & 1, pm = it / (2 * NCH);
        if ((pm & 15) == 0) continue;
        const int hc = 8 * ch, pn = hc >> 7, c = hc & 127;
        float o[8];
#pragma unroll
        for (int half = 0; half < 2; ++half) {
            f32x4 zc[2];
#pragma unroll
            for (int bj = 0; bj < 2; ++bj) {
                const size_t col2 = (size_t)pn * 256 + 128 * bj + c + 4 * half;
                const f32x4 z0 = *(const GAS f32x4*)(halo + ((size_t)(pm * 4 + r)) * FF2 + col2);
                const f32x4 z1 = (r == 1) ? *(const GAS f32x4*)(halo + ((size_t)(pm * 4 + 0)) * FF2 + col2) : *(const GAS f32x4*)(halo + ((size_t)((pm - 1) * 4 + 3)) * FF2 + col2);
                const f32x4 z2 = (r == 1) ? *(const GAS f32x4*)(halo + ((size_t)((pm - 1) * 4 + 3)) * FF2 + col2) : *(const GAS f32x4*)(halo + ((size_t)((pm - 1) * 4 + 2)) * FF2 + col2);
                const size_t oc = (size_t)bj * FF + hc + 4 * half;
                const f32x4 w0 = *(const GAS f32x4*)(cw + oc), w1 = *(const GAS f32x4*)(cw + FF2 + oc), w2 = *(const GAS f32x4*)(cw + 2 * (size_t)FF2 + oc), b = *(const GAS f32x4*)(cb + oc);
                zc[bj] = b + w0 * z2 + w1 * z1 + w2 * z0; }
#pragma unroll
            for (int e = 0; e < 4; ++e) o[4 * half + e] = silu_f(zc[0][e]) * zc[1][e];
        }
        *(GAS v4u*)(H + (size_t)(pm * 256 + r) * FF + hc) = pack8(o);
    }
}
__device__ __forceinline__ void ffn_fixup_local(int tid, int pmA, int pmB, const float* halo, bf16* H, const float* cw, const float* cb) {
    constexpr int NCH = FF / 8;
    const int npan = (pmB >= 0 && pmB != pmA) ? 2 : 1;
    for (int it = tid; it < npan * 2 * NCH; it += NWAVES * 64) {
        const int ch = it % NCH, r = (it / NCH) & 1, pm = (it >= 2 * NCH) ? pmB : pmA;
        if ((pm & 15) == 0) continue;
        const int hc = 8 * ch, pn = hc >> 7, c = hc & 127;
        float o[8];
#pragma unroll
        for (int half = 0; half < 2; ++half) {
            f32x4 zc[2];
#pragma unroll
            for (int bj = 0; bj < 2; ++bj) {
                const size_t col2 = (size_t)pn * 256 + 128 * bj + c + 4 * half;
                const f32x4 z0 = *(const GAS f32x4*)(halo + ((size_t)(pm * 4 + r)) * FF2 + col2);
                const f32x4 z1 = (r == 1) ? *(const GAS f32x4*)(halo + ((size_t)(pm * 4 + 0)) * FF2 + col2) : *(const GAS f32x4*)(halo + ((size_t)((pm - 1) * 4 + 3)) * FF2 + col2);
                const f32x4 z2 = (r == 1) ? *(const GAS f32x4*)(halo + ((size_t)((pm - 1) * 4 + 3)) * FF2 + col2) : *(const GAS f32x4*)(halo + ((size_t)((pm - 1) * 4 + 2)) * FF2 + col2);
                const size_t oc = (size_t)bj * FF + hc + 4 * half;
                const f32x4 w0 = *(const GAS f32x4*)(cw + oc), w1 = *(const GAS f32x4*)(cw + FF2 + oc), w2 = *(const GAS f32x4*)(cw + 2 * (size_t)FF2 + oc), b = *(const GAS f32x4*)(cb + oc);
                zc[bj] = b + w0 * z2 + w1 * z1 + w2 * z0; }
#pragma unroll
            for (int e = 0; e < 4; ++e) o[4 * half + e] = silu_f(zc[0][e]) * zc[1][e];
        }
        *(GAS v4u*)(H + (size_t)(pm * 256 + r) * FF + hc) = pack8(o);
    }
    asm volatile("s_waitcnt vmcnt(0)" ::: "memory");
    __syncthreads();
}
__device__ __forceinline__ void ret_scale_table(LAS float* tab, int tid, int pmA, int pmB, const float* ssp) {
    const int slot = tid >> 8, row = tid & 255, pm = slot ? pmB : pmA;
    if (pm >= 0) {
        float r[8];
#pragma unroll
        for (int h = 0; h < 8; ++h) { float a = 0.f;
#pragma unroll
            for (int sl = 0; sl < 16; ++sl) a += ssp[((size_t)(sl * 8 + h)) * M + pm * 256 + row];
            r[h] = rsqrtf(a * (1.0f / 512.0f) + EPS); }
#pragma unroll
        for (int h = 0; h < 8; ++h) tab[(slot * 256 + row) * 8 + h] = (h < 7) ? r[h] / r[h + 1] : r[7];
    }
    __syncthreads();
}
#define LDS_BARRIER() do { asm volatile("s_waitcnt lgkmcnt(0)" ::: "memory"); __builtin_amdgcn_s_barrier(); asm volatile("" ::: "memory"); } while (0)
#ifndef GATE_DB
#define GATE_DB 0
#endif
struct IC0 { static constexpr int value = 0; }; struct IC1 { static constexpr int value = 1; };
template <bool DUMMY_OUT = false> __device__ __forceinline__ void gating_phase(LAS unsigned char* lds, int vcu, int G, int tid, bf16* U, const bf16* V, const float* part, bf16* dummy,
                                             const float* lng, const float* lnb, const float* ws, const float* bs) {
    constexpr int WSP = 272, VTP = 576, MXP = 528, OFF_WS = 0, OFF_VT = 128 * WSP, OFF_ST = OFF_VT + 128 * VTP, OFF_SQ = OFF_ST + 1024, NUNITS = 8 * 128 * 3;
    static_assert(OFF_SQ + 4 * 128 * 8 <= RING_BYTES && MXP <= VTP, "gating LDS map");
    const int lane = tid & 63, wid = __builtin_amdgcn_readfirstlane(tid >> 6), th = wid >> 2, dq = wid & 3;
    const int l31 = lane & 31, h = lane >> 5, blk = (lane >> 4) & 1, q = (lane & 15) >> 2, p = lane & 3;
    const int dchunk = tid & 31, rg = tid >> 5;
    const int vpos = 32 * (dchunk >> 2) + 16 * (dchunk & 1) + 4 * ((dchunk & 3) >> 1);
    LAS const unsigned char* vt_rd = lds + OFF_VT + (8 * h + q) * VTP + (64 * dq + 16 * blk + 4 * p) * 2;
    LAS const unsigned char* ws_rd = lds + OFF_WS + (64 * th + l31) * WSP + 16 * h;
    LAS float* stl = (LAS float*)(lds + OFF_ST);
    LAS float* sql = (LAS float*)(lds + OFF_SQ);
    const int g = vcu & 7, wk = vcu >> 3, upw = NUNITS / G;
    for (int i = tid; i < 128 * 16; i += NWAVES * 64) { const int t = i >> 4, c8 = (i & 15) * 8; const GAS f32x4* wp = (const GAS f32x4*)(ws + ((size_t)g * 128 + t) * 128 + c8);
        const f32x4 a = wp[0], b = wp[1]; float f[8] = {a.x, a.y, a.z, a.w, b.x, b.y, b.z, b.w};
#pragma unroll
        for (int k = 0; k < 8; ++k) f[k] = (c8 + k <= t) ? f[k] : 0.f;
        *(LAS v4u*)(lds + OFF_WS + t * WSP + c8 * 2) = pack8(f); }
    const float bsv[2] = {bs[g * 128 + 64 * th + l31], bs[g * 128 + 64 * th + 32 + l31]};
    v4u vreg[1][8], ureg[GATE_DB ? 2 : 1][8];
    f32x2_t pn[8]; float sn1 = 0.f, sn2 = 0.f; bool pn_live = false;
    int ci_cur = -1;
#define GT_DECODE(k_, ci_, cb_) const int rest_ = wk * upw + (k_), ci_ = rest_ / 3, cb_ = rest_ % 3
#define GT_LOADV(dst, base, ci_, cb_) do { const bf16* vp_ = (base) + (size_t)(3 * g + (cb_)) * M * 256 + (size_t)((ci_) * 128 + rg) * 256 + 8 * dchunk; \
        _Pragma("unroll") for (int ps = 0; ps < 8; ++ps) dst[ps] = *(const GAS v4u*)(vp_ + (size_t)(16 * ps) * 256); } while (0)
#define GT_LOAD(dst, base, ci_, cb_) do { const bf16* vp_ = (base) + (size_t)((ci_) * 128 + rg) * GH + g * 768 + (cb_) * 256 + 8 * dchunk; \
        _Pragma("unroll") for (int ps = 0; ps < 8; ++ps) dst[ps] = *(const GAS v4u*)(vp_ + (size_t)(16 * ps) * GH); } while (0)
#define GT_LNW(cb_) do { const GAS f32x4* gp_ = (const GAS f32x4*)(lng + g * 768 + (cb_) * 256 + 8 * dchunk); const GAS f32x4* bp_ = (const GAS f32x4*)(lnb + g * 768 + (cb_) * 256 + 8 * dchunk); \
        lnw[0] = gp_[0]; lnw[1] = gp_[1]; lnw[2] = bp_[0]; lnw[3] = bp_[1]; } while (0)
    f32x4 lnw[4];
    { GT_DECODE(0, ci0, cb0); GT_LOADV(vreg[0], V, ci0, cb0); GT_LOAD(ureg[0], U, ci0, cb0); GT_LNW(cb0); }
    auto unit_body = [&](const int k, auto PC) { constexpr int P = GATE_DB ? decltype(PC)::value : 0, Q = GATE_DB ? 1 - P : 0;
        GT_DECODE(k, ci, cb); const int m0 = ci * 128, ch0 = g * 768 + cb * 256;
        if (GATE_DB && k + 1 < upw) { GT_DECODE(k + 1, cin, cbn); GT_LOAD(ureg[Q], U, cin, cbn); }
        if (cb != 0 && pn_live) {
#pragma unroll
            for (int sl = 0; sl < 8; ++sl) { sn1 += pn[sl].x; sn2 += pn[sl].y; }
            pn_live = false; }
        if (ci != ci_cur) {
            { const int row = tid & 127, qq = tid >> 7; float a1 = 0.f, a2 = 0.f;
              if (k == 0) { const GAS f32x2_t* pp = (const GAS f32x2_t*)part + (size_t)(24 * qq) * M + m0 + row;
#pragma unroll 8
                  for (int sl = 0; sl < 24; ++sl) { const f32x2_t v = pp[(size_t)sl * M]; a1 += v.x; a2 += v.y; } }
              else { a1 = sn1; a2 = sn2;
#pragma unroll
                  for (int sl = 0; sl < 8; ++sl) { a1 += pn[sl].x; a2 += pn[sl].y; }
                  pn_live = false; }
              sn1 = 0.f; sn2 = 0.f;
              sql[(qq * 128 + row) * 2] = a1; sql[(qq * 128 + row) * 2 + 1] = a2; }
            LDS_BARRIER();
            if (tid < 128) { float a1 = 0.f, a2 = 0.f;
#pragma unroll
                for (int qq = 0; qq < 4; ++qq) { a1 += sql[(qq * 128 + tid) * 2]; a2 += sql[(qq * 128 + tid) * 2 + 1]; }
                const float mean = a1 * (1.0f / GH), var = a2 * (1.0f / GH) - mean * mean; stl[2 * tid] = mean; stl[2 * tid + 1] = rsqrtf(fmaxf(var, 0.f) + EPS); }
            LDS_BARRIER();
            ci_cur = ci;
        }
        {
            const f32x4 ga = lnw[0], gb = lnw[1], ba = lnw[2], bb = lnw[3];
            const float gg[8] = {ga.x, ga.y, ga.z, ga.w, gb.x, gb.y, gb.z, gb.w}, bb8[8] = {ba.x, ba.y, ba.z, ba.w, bb.x, bb.y, bb.z, bb.w};
#pragma unroll
            for (int ps = 0; ps < 8; ++ps) { const int s = rg + 16 * ps; const float mu = stl[2 * s], rstd = stl[2 * s + 1];
                float f[8]; unpack8(vreg[0][ps], f);
#pragma unroll
                for (int kk = 0; kk < 8; ++kk) f[kk] = (f[kk] - mu) * rstd * gg[kk] + bb8[kk];
                LAS unsigned char* wp = lds + OFF_VT + s * VTP + vpos * 2;
                *(LAS v2u*)wp = (v2u){pkbf(f[0], f[1]), pkbf(f[2], f[3])}; *(LAS v2u*)(wp + 16) = (v2u){pkbf(f[4], f[5]), pkbf(f[6], f[7])}; }
        }
        LDS_BARRIER();
        if (k + 1 < upw) { GT_DECODE(k + 1, ci2, cb2); GT_LOADV(vreg[0], V, ci2, cb2); GT_LNW(cb2); }
        if (k + 3 - cb < upw) {
            const GAS f32x2_t* pp = (const GAS f32x2_t*)part + (size_t)(24 * (tid >> 7) + 8 * cb) * M + m0 + 128 + (tid & 127);
#pragma unroll
            for (int sl = 0; sl < 8; ++sl) pn[sl] = pp[(size_t)sl * M];
            pn_live = true; }
        f32x16 acc[2][2];
#pragma unroll
        for (int dt = 0; dt < 2; ++dt)
#pragma unroll
            for (int tt = 0; tt < 2; ++tt) acc[dt][tt] = zero16();
        auto mix_steps = [&](auto THC) { constexpr int TH = decltype(THC)::value, NKS = (64 * TH + 63) / 16 + 1;
#pragma unroll
            for (int ks = 0; ks < NKS; ++ks) {
                bf16x8 af[2], bfr[2];
#pragma unroll
                for (int dt = 0; dt < 2; ++dt) af[dt] = cat8(tr_rd(vt_rd + (16 * ks) * VTP + dt * 64), tr_rd(vt_rd + (16 * ks + 4) * VTP + dt * 64));
#pragma unroll
                for (int tt = 0; tt < 2; ++tt) bfr[tt] = *(LAS const bf16x8*)(ws_rd + (32 * tt) * WSP + 32 * ks);
#pragma unroll
                for (int dt = 0; dt < 2; ++dt)
#pragma unroll
                    for (int tt = 0; tt < 2; ++tt) if (16 * ks <= 64 * TH + 32 * tt + 31) acc[dt][tt] = MFMA32(af[dt], bfr[tt], acc[dt][tt]); }
        };
        if (th == 0) mix_steps(IC0{}); else mix_steps(IC1{});
        LDS_BARRIER();
#pragma unroll
        for (int dt = 0; dt < 2; ++dt)
#pragma unroll
            for (int tt = 0; tt < 2; ++tt) { float o[16];
#pragma unroll
                for (int i = 0; i < 16; ++i) o[i] = acc[dt][tt][i] + bsv[tt];
                LAS unsigned char* mp = lds + OFF_VT + (64 * th + 32 * tt + l31) * MXP + (64 * dq + 32 * dt + 16 * h) * 2;
                v4u w0, w1; w0.x = pkbf(o[0], o[1]); w0.y = pkbf(o[2], o[3]); w0.z = pkbf(o[4], o[5]); w0.w = pkbf(o[6], o[7]); w1.x = pkbf(o[8], o[9]); w1.y = pkbf(o[10], o[11]); w1.z = pkbf(o[12], o[13]); w1.w = pkbf(o[14], o[15]);
                *(LAS v4u*)mp = w0; *(LAS v4u*)(mp + 16) = w1; }
        LDS_BARRIER();
        {
            bf16* up = DUMMY_OUT ? dummy + (size_t)((m0 + rg) & 4095) * GH + ch0 + 8 * dchunk : U + (size_t)(m0 + rg) * GH + ch0 + 8 * dchunk;
#pragma unroll
            for (int ps = 0; ps < 8; ++ps) { const v4u mw = *(LAS const v4u*)(lds + OFF_VT + (rg + 16 * ps) * MXP + dchunk * 16); float mf[8], uf[8], o[8]; unpack8(mw, mf); unpack8(ureg[P][ps], uf);
#pragma unroll
                for (int kk = 0; kk < 8; ++kk) o[kk] = uf[kk] * mf[kk];
                *(GAS v4u*)(up + (size_t)(16 * ps) * GH) = pack8(o); }
        }
        if (!GATE_DB && k + 1 < upw) { GT_DECODE(k + 1, ci3, cb3); GT_LOAD(ureg[Q], U, ci3, cb3); }
        LDS_BARRIER();
    };
    for (int k = 0; k < upw; k += 2) { unit_body(k, IC0{}); if (k + 1 < upw) unit_body(k + 1, IC1{}); }
#undef GT_DECODE
#undef GT_LOAD
#undef GT_LOADV
#undef GT_LNW
}

__device__ __forceinline__ unsigned offb(unsigned row, unsigned ch) { return 256u * row + 16u * (ch ^ (((row & 3u) << 2) | ((row >> 2) & 3u))); }
#ifndef RET_GP
#define RET_GP false
#endif
#ifdef PROBE_RAB
#define RET_GP_DECL , const bool GP = false
#define RET_GP_T
#else
#define RET_GP_DECL
#define RET_GP_T , bool GP = RET_GP
#endif
constexpr int RPS = 256;
template <bool STORE = true, bool DO_S = true, bool EXT_P = false RET_GP_T> __device__ __forceinline__ void retention_phase(LAS unsigned char* lds, int vcu, int G, int tid, const bf16* proj, bf16* oraw, float* ssp, const bf16* Pbuf = nullptr RET_GP_DECL) {
    constexpr int OFF_Q = 0, OFF_K = 32768, OFF_V = 65536, VP = 192, OFF_R = OFF_V + 128 * VP, RP = 528, PP = 272;
    static_assert(OFF_R + 64 * RP <= RING_BYTES && 128 * PP <= OFF_V, "retention LDS map");
    const int lane = tid & 63, wid = __builtin_amdgcn_readfirstlane(tid >> 6), wh = wid >> 1, wl = wid & 1;
    const int l31 = lane & 31, h = lane >> 5, blk = (lane >> 4) & 1, q = (lane & 15) >> 2, p = lane & 3;
    const int qch = tid & 15, qr = tid >> 4;
    const int vch = tid & 7, vr = tid >> 3;
    const int vpos = 32 * (vch >> 2) + 16 * (vch & 1) + 4 * ((vch & 3) >> 1);
    const unsigned xsw = (((unsigned)l31 & 3u) << 2) | (((unsigned)l31 >> 2) & 3u);
    const unsigned kfA_c = OFF_K + 256u * (32u * wh + l31) + 16u * ((unsigned)h ^ xsw);
    const unsigned q0A_c = OFF_Q + 256u * (64u * wl + l31) + 16u * ((unsigned)h ^ xsw);
    const unsigned rfA = OFF_R + (32u * wl + l31) * RP + 16u * h;
    const unsigned ccK = 4u * wh + 2u * blk + ((unsigned)p >> 1);
    const unsigned katA = OFF_K + 256u * (8u * h + q) + 16u * (ccK ^ ((((unsigned)q) << 2) | (2u * h))) + 8u * (p & 1);
    const unsigned katB = OFF_K + 256u * (8u * h + q + 4u) + 16u * (ccK ^ ((((unsigned)q) << 2) | (2u * h + 1u))) + 8u * (p & 1);
    const unsigned vtA = OFF_V + (8u * h + q) * VP + (32u * wl + 16u * blk + 4u * p) * 2u;
    const unsigned pfA = (32u * wh + l31) * PP + 16u * h;
    for (int unit = vcu; unit < 256; unit += G) {
        const int bh = unit >> 3, sl = unit & 7, b = bh >> 3, hd = bh & 7;
        const float lg = log1pf(-exp2f(-5.0f - (float)hd));
        const float cd = expf(128.0f * lg);
        const float vsc0 = expf((float)(127 - vr) * lg), vsc1 = expf((float)(63 - vr) * lg);
        const float sI = expf((float)(32 * wh + l31 - 127) * lg), sX = expf((float)(32 * wh + l31 + 1) * lg);
        const bf16* qg = proj + (size_t)hd * M * RPS + (size_t)(b * SEQ) * RPS; const bf16* kg = proj + (size_t)(8 + hd) * M * RPS + (size_t)(b * SEQ) * RPS;
        const bf16* vg = proj + (size_t)(16 + 2 * hd + (sl >> 2)) * M * RPS + (size_t)(b * SEQ) * RPS + (sl & 3) * 64;
        for (int i = tid; i < 64 * RP / 16; i += NWAVES * 64) ((LAS v4u*)(lds + OFF_R))[i] = (v4u){0u, 0u, 0u, 0u};
        f32x16 Racc[2] = {zero16(), zero16()}, X = zero16();
        v4u qreg[4], kreg[4], vreg[2], preg[4];
#pragma unroll
        for (int i = 0; i < 4; ++i) { qreg[i] = *(const GAS v4u*)(qg + (size_t)(qr + 32 * i) * RPS + 8 * qch); kreg[i] = *(const GAS v4u*)(kg + (size_t)(qr + 32 * i) * RPS + 8 * qch); }
#pragma unroll
        for (int i = 0; i < 2; ++i) vreg[i] = *(const GAS v4u*)(vg + (size_t)(vr + 64 * i) * RPS + 8 * vch);
        LAS v4u* gslot = (LAS v4u*)(lds + TAIL_OFF + tid * 32);
        const bf16* ggs = proj + (size_t)(32 + 2 * hd + (sl >> 2)) * M * RPS + (size_t)(b * SEQ) * RPS + (sl & 3) * 64;
        const unsigned ggo = (unsigned)((32 * wh + l31) * RPS + 32 * wl + 16 * h);
#define ggp (ggs + ggo)
        v4u gq0, gq1; if (GP) { gq0 = ((const GAS v4u*)ggp)[0]; gq1 = ((const GAS v4u*)ggp)[1]; }
        LDS_BARRIER();
        for (int ci = 0; ci < 32; ++ci) {
            const int m0 = b * SEQ + ci * 128;
            f32x16 S[2] = {zero16(), zero16()};
#pragma unroll
            for (int st = 0; st < 2; ++st) {
#pragma unroll
                for (int i = 0; i < 4; ++i) { *(LAS v4u*)(lds + OFF_Q + offb(qr + 32 * i, qch)) = qreg[i]; *(LAS v4u*)(lds + OFF_K + offb(qr + 32 * i, qch)) = kreg[i]; }
                if (st == 0) {
                    if (GP) { gslot[0] = gq0; gslot[1] = gq1; }
#pragma unroll
                    for (int i = 0; i < 2; ++i) { const int s = vr + 64 * i; const float sc = i ? vsc1 : vsc0; float f[8]; unpack8(vreg[i], f);
#pragma unroll
                        for (int k = 0; k < 8; ++k) f[k] *= sc;
                        LAS unsigned char* wp = lds + OFF_V + s * VP + vpos * 2;
                        *(LAS v2u*)wp = (v2u){pkbf(f[0], f[1]), pkbf(f[2], f[3])}; *(LAS v2u*)(wp + 16) = (v2u){pkbf(f[4], f[5]), pkbf(f[6], f[7])}; }
                }
                if (EXT_P && st == 0) { const bf16* pg_ = Pbuf + ((size_t)(bh * 32 + ci)) * 16384 + (size_t)qr * 128 + 8 * qch;
#pragma unroll
                    for (int i = 0; i < 4; ++i) preg[i] = *(const GAS v4u*)(pg_ + (size_t)(32 * i) * 128); }
                { const int cn = (st == 0) ? ci : ci + 1, dk0 = (st == 0) ? 128 : 0;
                  if (cn < 32) {
#pragma unroll
                      for (int i = 0; i < 4; ++i) { qreg[i] = *(const GAS v4u*)(qg + (size_t)(cn * 128 + qr + 32 * i) * RPS + dk0 + 8 * qch); kreg[i] = *(const GAS v4u*)(kg + (size_t)(cn * 128 + qr + 32 * i) * RPS + dk0 + 8 * qch); }
                      if (st == 1) {
#pragma unroll
                          for (int i = 0; i < 2; ++i) vreg[i] = *(const GAS v4u*)(vg + (size_t)(cn * 128 + vr + 64 * i) * RPS + 8 * vch); } } }
                LDS_BARRIER();
#pragma unroll
                for (int i = 0; i < 16; ++i) Racc[st][i] *= cd;
#define RT_LOAD(F, ks_) do { const unsigned kx = (unsigned)(ks_) << 5; \
                    if (DO_S) { F.kf = *(LAS const bf16x8*)(lds + (kfA ^ kx)); F.q0 = *(LAS const bf16x8*)(lds + (q0A ^ kx)); F.q1 = *(LAS const bf16x8*)(lds + (q0A ^ kx) + 8192); } \
                    F.rf = *(LAS const bf16x8*)(lds + rfA + (128 * st + 16 * (ks_)) * 2); F.qx = *(LAS const bf16x8*)(lds + (kfA ^ kx) - (OFF_K - OFF_Q)); \
                    F.ka = cat8(tr_rd(lds + katA + 4096 * (ks_)), tr_rd(lds + katB + 4096 * (ks_))); F.vb = cat8(tr_rd(lds + vtA + 16 * VP * (ks_)), tr_rd(lds + vtA + 16 * VP * (ks_) + 4 * VP)); } while (0)
#define RT_MMA(F) do { if (DO_S) { S[0] = MFMA32(F.kf, F.q0, S[0]); S[1] = MFMA32(F.kf, F.q1, S[1]); } X = MFMA32(F.rf, F.qx, X); Racc[st] = MFMA32(F.ka, F.vb, Racc[st]); } while (0)
                { struct Fr { bf16x8 kf, q0, q1, rf, qx, ka, vb; } fa, fb;
                  unsigned kfA = kfA_c, q0A = q0A_c; asm volatile("" : "+v"(kfA), "+v"(q0A));
                  RT_LOAD(fa, 0);
#pragma unroll
                  for (int ks = 0; ks < 8; ks += 2) {
                      RT_LOAD(fb, ks + 1); __builtin_amdgcn_sched_barrier(0);
                      RT_MMA(fa); __builtin_amdgcn_sched_barrier(0);
                      if (ks + 2 < 8) { RT_LOAD(fa, ks + 2); } __builtin_amdgcn_sched_barrier(0);
                      RT_MMA(fb); __builtin_amdgcn_sched_barrier(0);
                  } }
#undef RT_LOAD
#undef RT_MMA
                LDS_BARRIER();
            }
#pragma unroll
            for (int jj = 0; jj < 2; ++jj) { if (EXT_P) break; const int c = 64 * wl + 32 * jj + l31;
#pragma unroll
                for (int g4 = 0; g4 < 4; ++g4) { const int s0 = 32 * wh + 8 * g4 + 4 * h; float f[4];
#pragma unroll
                    for (int e = 0; e < 4; ++e) f[e] = (c >= s0 + e) ? S[jj][4 * g4 + e] : 0.f;
                    *(LAS v2u*)(lds + c * PP + s0 * 2) = (v2u){pkbf(f[0], f[1]), pkbf(f[2], f[3])}; } }
            if (EXT_P) {
#pragma unroll
                for (int i = 0; i < 4; ++i) *(LAS v4u*)(lds + (qr + 32 * i) * PP + qch * 16) = preg[i]; }
#pragma unroll
            for (int st = 0; st < 2; ++st)
#pragma unroll
                for (int g4 = 0; g4 < 4; ++g4) { const int dk0 = 128 * st + 32 * wh + 8 * g4 + 4 * h;
                    *(LAS v2u*)(lds + OFF_R + (32 * wl + l31) * RP + dk0 * 2) = (v2u){pkbf(Racc[st][4 * g4], Racc[st][4 * g4 + 1]), pkbf(Racc[st][4 * g4 + 2], Racc[st][4 * g4 + 3])}; }
            LDS_BARRIER();
            f32x16 I = zero16();
            v4u g0, g1; if (GP) { g0 = gslot[0]; g1 = gslot[1]; } else { const GAS v4u* gp_ = (const GAS v4u*)(ggp + (size_t)(ci * 128) * RPS); g0 = gp_[0]; g1 = gp_[1]; }
            { bf16x8 va0, pf0, va1, pf1;
#define PV_LOAD(VA, PF, ks_) do { VA = cat8(tr_rd(lds + vtA + 16 * VP * (ks_)), tr_rd(lds + vtA + 16 * VP * (ks_) + 4 * VP)); PF = *(LAS const bf16x8*)(lds + pfA + 32 * (ks_)); } while (0)
              PV_LOAD(va0, pf0, 0);
#pragma unroll
              for (int ks = 0; ks < 8; ks += 2) {
                  PV_LOAD(va1, pf1, ks + 1); __builtin_amdgcn_sched_barrier(0);
                  I = MFMA32(va0, pf0, I); __builtin_amdgcn_sched_barrier(0);
                  if (ks + 2 < 8) { PV_LOAD(va0, pf0, ks + 2); } __builtin_amdgcn_sched_barrier(0);
                  I = MFMA32(va1, pf1, I); __builtin_amdgcn_sched_barrier(0);
              }
#undef PV_LOAD
            }
            { const int c = 32 * wh + l31; float o[16], gv[16]; float sq = 0.f;
              { float a8[8], b8[8]; unpack8(g0, a8); unpack8(g1, b8);
#pragma unroll
                for (int i = 0; i < 8; ++i) { gv[i] = a8[i]; gv[8 + i] = b8[i]; } }
#pragma unroll
              for (int i = 0; i < 16; ++i) { o[i] = sI * I[i] + sX * X[i]; sq += o[i] * o[i]; o[i] *= silu_f(gv[i]); }
              sq += __builtin_bit_cast(float, __builtin_amdgcn_ds_bpermute((int)(((unsigned)lane ^ 32u) << 2), __builtin_bit_cast(int, sq)));
              if (STORE && h == 0) ssp[((size_t)(2 * sl + wl) * 8 + hd) * M + m0 + c] = sq;
              GAS v4u* op = (GAS v4u*)(oraw + (size_t)(m0 + c) * RV + hd * 512 + sl * 64 + 32 * wl + 16 * h);
              v4u w0, w1; w0.x = pkbf(o[0], o[1]); w0.y = pkbf(o[2], o[3]); w0.z = pkbf(o[4], o[5]); w0.w = pkbf(o[6], o[7]); w1.x = pkbf(o[8], o[9]); w1.y = pkbf(o[10], o[11]); w1.z = pkbf(o[12], o[13]); w1.w = pkbf(o[14], o[15]);
              if (STORE) { op[0] = w0; op[1] = w1; } else { asm volatile("" :: "v"(w0), "v"(w1)); } X = zero16(); }
            if (GP) { const GAS v4u* gn_ = (const GAS v4u*)(ggp + (size_t)((ci + 1 < 32 ? ci + 1 : ci) * 128) * RPS); gq0 = gn_[0]; gq1 = gn_[1]; }
            LDS_BARRIER();
        }
    }
}

#undef ggp
__device__ __forceinline__ void ret_scores_phase(LAS unsigned char* lds, int vcu, int G, int tid, const bf16* proj, bf16* Pbuf) {
    const int lane = tid & 63, wid = __builtin_amdgcn_readfirstlane(tid >> 6), wh = wid >> 1, wl = wid & 1;
    const int l31 = lane & 31, h = lane >> 5;
    const int qch = tid & 15, qr = tid >> 4;
    const unsigned xsw = (((unsigned)l31 & 3u) << 2) | (((unsigned)l31 >> 2) & 3u);
    const unsigned kfA = 65536u + 256u * (32u * wh + l31) + 16u * ((unsigned)h ^ xsw);
    const unsigned q0A = 256u * (64u * wl + l31) + 16u * ((unsigned)h ^ xsw);
    for (int unit = vcu; unit < 1024; unit += G) {
        const int bh = unit >> 5, ci = unit & 31, b = bh >> 3, hd = bh & 7;
        const bf16* qg = proj + (size_t)(b * SEQ + ci * 128) * RPROJ + hd * 256; const bf16* kg = qg + 2048;
        v4u qreg[2][4], kreg[2][4];
#pragma unroll
        for (int hf = 0; hf < 2; ++hf)
#pragma unroll
            for (int i = 0; i < 4; ++i) { qreg[hf][i] = *(const GAS v4u*)(qg + (size_t)(qr + 32 * i) * RPROJ + 128 * hf + 8 * qch); kreg[hf][i] = *(const GAS v4u*)(kg + (size_t)(qr + 32 * i) * RPROJ + 128 * hf + 8 * qch); }
#pragma unroll
        for (int hf = 0; hf < 2; ++hf)
#pragma unroll
            for (int i = 0; i < 4; ++i) { *(LAS v4u*)(lds + 32768 * hf + offb(qr + 32 * i, qch)) = qreg[hf][i]; *(LAS v4u*)(lds + 65536 + 32768 * hf + offb(qr + 32 * i, qch)) = kreg[hf][i]; }
        LDS_BARRIER();
        f32x16 S[2] = {zero16(), zero16()};
#pragma unroll
        for (int hf = 0; hf < 2; ++hf)
#pragma unroll 4
            for (int ks = 0; ks < 8; ++ks) { const unsigned kx = (unsigned)ks << 5;
                const bf16x8 kf = *(LAS const bf16x8*)(lds + 32768 * hf + (kfA ^ kx)), q0 = *(LAS const bf16x8*)(lds + 32768 * hf + (q0A ^ kx)), q1 = *(LAS const bf16x8*)(lds + 32768 * hf + (q0A ^ kx) + 8192);
                S[0] = MFMA32(kf, q0, S[0]); S[1] = MFMA32(kf, q1, S[1]); }
        bf16* pg = Pbuf + (size_t)unit * 16384;
#pragma unroll
        for (int jj = 0; jj < 2; ++jj) { const int c = 64 * wl + 32 * jj + l31;
#pragma unroll
            for (int g4 = 0; g4 < 4; ++g4) { const int s0 = 32 * wh + 8 * g4 + 4 * h; float f[4];
#pragma unroll
                for (int e = 0; e < 4; ++e) f[e] = (c >= s0 + e) ? S[jj][4 * g4 + e] : 0.f;
                *(GAS v2u*)(pg + (size_t)c * 128 + s0) = (v2u){pkbf(f[0], f[1]), pkbf(f[2], f[3])}; } }
        LDS_BARRIER();
    }
}
struct Args { const void* in[18]; float* out; unsigned char* ws; int ph_lo, ph_hi; };
constexpr int N_PHASES = 19;
__global__ void __launch_bounds__(NWAVES * 64, 2) mega_fwd(Args args) {
    extern __shared__ __attribute__((aligned(16))) unsigned char lds_raw[];
    LAS unsigned char* lds = (LAS unsigned char*)lds_raw;
    volatile LAS unsigned* MISC = (volatile LAS unsigned*)(lds + MISC_OFF);
    const int tid = threadIdx.x, lane = tid & 63, wave = __builtin_amdgcn_readfirstlane(tid >> 6);
    const int G = gridDim.x, bx = blockIdx.x, vcu = (G % 8 == 0) ? (bx % 8) * (G / 8) + bx / 8 : bx;
    const int gw = vcu * NWAVES + wave, NGW = G * NWAVES;
    unsigned char* ws = args.ws;
    gu32* ctl = (gu32*)(ws + WS_CTL);
    for (int u = tid; u < (LDS_BYTES - LDSCTL_OFF) / 4; u += NWAVES * 64) ((LAS unsigned*)(lds + LDSCTL_OFF))[u] = 0u;
    __syncthreads();
    XcdBarrier bar = xcd_barrier_post((unsigned*)(ctl + CW_BAR), MISC + 8);
    const float* x = (const float*)args.in[0]; const int* positions = (const int*)args.in[1];
    const float* mix_pre_g = (const float*)args.in[2]; const float* mix_post_g = (const float*)args.in[3];
    const float* gmlp_w_in = (const float*)args.in[4]; const float* gmlp_ln_g = (const float*)args.in[5]; const float* gmlp_ln_b = (const float*)args.in[6];
    const float* gmlp_w_s = (const float*)args.in[7]; const float* gmlp_b_s = (const float*)args.in[8]; const float* gmlp_w_out = (const float*)args.in[9];
    const float* ret_w_in = (const float*)args.in[10]; const float* ret_w_out = (const float*)args.in[11];
    const float* ffn_pre_g = (const float*)args.in[12]; const float* ffn_post_g = (const float*)args.in[13];
    const float* ffn_w_up = (const float*)args.in[14]; const float* ffn_conv_w = (const float*)args.in[15]; const float* ffn_conv_b = (const float*)args.in[16]; const float* ffn_w_down = (const float*)args.in[17];
    float* out = args.out;
    bf16* WA = (bf16*)(ws + WS_WA); bf16* WB = (bf16*)(ws + WS_WB); bf16* HN = (bf16*)(ws + WS_HN); bf16* BIG = (bf16*)(ws + WS_BIG); bf16* H2 = (bf16*)(ws + WS_H2);
    bf16* XB = (bf16*)out; bf16* XB3 = BIG + (size_t)32 * MiB; float* RS = (float*)(ws + WS_STATS + ST_SS);
    float* st_s1 = (float*)(ws + WS_STATS + ST_S1); float* st_s2 = (float*)(ws + WS_STATS + ST_S2);
    const int lo = args.ph_lo, hi = args.ph_hi;
#define IN(k) (lo <= (k) && (k) < hi)
#ifndef DOUBLE_MASK
#define DOUBLE_MASK 0
#endif
#define REP(k) _Pragma("unroll") for (int rep_ = 0; rep_ < 1 + ((DOUBLE_MASK >> (k)) & 1); ++rep_) if ((rep_ ? (__syncthreads(), 0) : 0), true)
#ifdef PROBE_CLOCK
    unsigned long long pc_t0 = 0, pc_r0 = 0;
#define PCLK_BEGIN(k) do { if ((k) == PROBE_PH && bx == PROBE_CLOCK && tid == 0) { pc_t0 = __builtin_amdgcn_s_memtime(); pc_r0 = __builtin_amdgcn_s_memrealtime(); } } while (0)
#define PCLK_END(k) do { if ((k) == PROBE_PH && bx == PROBE_CLOCK && tid == 0) { const unsigned long long t1 = __builtin_amdgcn_s_memtime(), r1 = __builtin_amdgcn_s_memrealtime(); const float ghz = (float)(t1 - pc_t0) / (float)(r1 - pc_r0) * 0.1f; const float cyc = (float)(t1 - pc_t0); const float us = (float)(r1 - pc_r0) * 0.01f; \
        const float val = (PROBE_KIND == 0) ? ghz : (PROBE_KIND == 1) ? cyc : us; \
        __hip_atomic_store((float*)(ctl + CW_DBG), (val > PROBE_THR) ? 10.0f : 0.0f, __ATOMIC_RELAXED, __HIP_MEMORY_SCOPE_AGENT); } } while (0)
#else
#define PCLK_BEGIN(k) do { } while (0)
#define PCLK_END(k) do { } while (0)
#endif
#define OPQ_LANE() ({ int tq_ = tid; asm volatile("" : "+v"(tq_)); tq_ & 63; })
#define SEAM(k) do { PCLK_END(k); if (IN(k) && IN((k) + 1)) xcd_barrier(bar); } while (0)
#define SEAM2(k) do { PCLK_END(k); if (IN(k) && IN((k) + 2)) xcd_barrier(bar); } while (0)
#ifndef KNOB_ALIGN
#define KNOB_ALIGN true
#endif
#ifndef KNOB_SP2
#define KNOB_SP2 true
#endif
#ifndef KNOB_EB
#define KNOB_EB 0
#endif
#ifndef KNOB_CG4
#define KNOB_CG4 1
#endif
#if KNOB_CG4
typedef pg8::EpiConvGate4 EpiCG;
#else
typedef pg8::EpiConvGate EpiCG;
#endif
#ifndef KNOB_BAL
#define KNOB_BAL false
#endif
#ifdef PROBE_NOSTORE
#define GEMM(EPI, Aptr, Bptr, Nn, Kk, Eobj) do { pg8::Gemm g_{(const pg8::bf16_t*)(Aptr), (const pg8::bf16_t*)(Bptr), M, (Nn), (Kk)}; pg8::StaticOrder S_; S_.init(M, (Nn), G, bx); \
        if (rep_ == 0) pg8::gemm_phase<EPI, pg8::StaticOrder, true, true>(lds, g_, S_, (Eobj)); else { pg8::EpiNull En_; pg8::gemm_phase<pg8::EpiNull, pg8::StaticOrder, true, true>(lds, g_, S_, En_); } } while (0)
#else
#define GEMM(EPI, Aptr, Bptr, Nn, Kk, Eobj) do { pg8::Gemm g_{(const pg8::bf16_t*)(Aptr), (const pg8::bf16_t*)(Bptr), M, (Nn), (Kk)}; pg8::StaticOrder S_; S_.init(M, (Nn), G, bx); \
        pg8::gemm_phase<EPI, pg8::StaticOrder, (EPI::NEEDS_ALIGN || KNOB_ALIGN), KNOB_SP2, KNOB_BAL, KNOB_EB>(lds, g_, S_, (Eobj)); } while (0)
#endif

    PCLK_BEGIN(0);
#ifdef PROBE_CVT2
#define CVT_REPEAT int nr2_ = 2; asm volatile("" : "+s"(nr2_)); _Pragma("unroll 1") for (int r2_ = 0; r2_ < nr2_; ++r2_)
#else
#define CVT_REPEAT
#endif
#ifdef CVT_STAGB
#define CVT_PRE(ILV, W, Kk, Nn, WT) do { int tq_ = tid; asm volatile("" : "+v"(tq_)); convert_weight_stagb<ILV>((W), (Kk), (Nn), (WT), lds, bx, G, tq_, 0); } while (0)
#define CVT_POST(ILV, W, Kk, Nn, WT) do { __syncthreads(); int tq_ = tid; asm volatile("" : "+v"(tq_)); convert_weight_stagb<ILV>((W), (Kk), (Nn), (WT), lds, bx, G, tq_, 1); } while (0)
#define CVT_PRE_G(ILV, W, Kk, Nn, WT, Gk) do { int tq_ = tid; asm volatile("" : "+v"(tq_)); convert_weight_stagb<ILV, true>((W), (Kk), (Nn), (WT), lds, bx, G, tq_, 0, (Gk)); } while (0)
#define CVT_POST_G(ILV, W, Kk, Nn, WT, Gk) do { __syncthreads(); int tq_ = tid; asm volatile("" : "+v"(tq_)); convert_weight_stagb<ILV, true>((W), (Kk), (Nn), (WT), lds, bx, G, tq_, 1, (Gk)); } while (0)
#elif defined(CVT_STAG)
#define CVT_PRE(ILV, W, Kk, Nn, WT) do { int ln_ = lane; asm volatile("" : "+v"(ln_)); convert_weight_stag<ILV>((W), (Kk), (Nn), (WT), lds, bx, G, wave, ln_, 0); __syncthreads(); } while (0)
#define CVT_POST(ILV, W, Kk, Nn, WT) do { __syncthreads(); int ln_ = lane; asm volatile("" : "+v"(ln_)); convert_weight_stag<ILV>((W), (Kk), (Nn), (WT), lds, bx, G, wave, ln_, 1); } while (0)
#define CVT_PRE_G(ILV, W, Kk, Nn, WT, Gk) do { int ln_ = lane; asm volatile("" : "+v"(ln_)); convert_weight_stag<ILV, true>((W), (Kk), (Nn), (WT), lds, bx, G, wave, ln_, 0, (Gk)); __syncthreads(); } while (0)
#define CVT_POST_G(ILV, W, Kk, Nn, WT, Gk) do { __syncthreads(); int ln_ = lane; asm volatile("" : "+v"(ln_)); convert_weight_stag<ILV, true>((W), (Kk), (Nn), (WT), lds, bx, G, wave, ln_, 1, (Gk)); } while (0)
#else
#ifdef CVT_ALL_PRE
#define CVT_PRE(ILV, W, Kk, Nn, WT) do { { int ln_ = lane; asm volatile("" : "+v"(ln_)); CVT_REPEAT convert_weight_grp<ILV>((W), (Kk), (Nn), (WT), lds, (bx & 1), (bx >> 1) * NWAVES + wave, (G >> 1) * NWAVES, wave, ln_); __syncthreads(); } } while (0)
#else
#define CVT_PRE(ILV, W, Kk, Nn, WT) do { if (!(bx & 1)) { int ln_ = lane; asm volatile("" : "+v"(ln_)); CVT_REPEAT convert_weight_grp<ILV>((W), (Kk), (Nn), (WT), lds, 0, (bx >> 1) * NWAVES + wave, (G >> 1) * NWAVES, wave, ln_); __syncthreads(); } } while (0)
#endif
#ifdef CVT_ALL_PRE
#define CVT_POST(ILV, W, Kk, Nn, WT) do { } while (0)
#else
#define CVT_POST(ILV, W, Kk, Nn, WT) do { if (bx & 1) { __syncthreads(); int ln_ = lane; asm volatile("" : "+v"(ln_)); CVT_REPEAT convert_weight_grp<ILV>((W), (Kk), (Nn), (WT), lds, 1, (bx >> 1) * NWAVES + wave, (G >> 1) * NWAVES, wave, ln_); } } while (0)
#endif
#ifdef CVT_ALL_PRE
#define CVT_PRE_G(ILV, W, Kk, Nn, WT, Gk) do { { int ln_ = lane; asm volatile("" : "+v"(ln_)); CVT_REPEAT convert_weight_grp<ILV, true>((W), (Kk), (Nn), (WT), lds, (bx & 1), (bx >> 1) * NWAVES + wave, (G >> 1) * NWAVES, wave, ln_, (Gk)); __syncthreads(); } } while (0)
#else
#define CVT_PRE_G(ILV, W, Kk, Nn, WT, Gk) do { if (!(bx & 1)) { int ln_ = lane; asm volatile("" : "+v"(ln_)); CVT_REPEAT convert_weight_grp<ILV, true>((W), (Kk), (Nn), (WT), lds, 0, (bx >> 1) * NWAVES + wave, (G >> 1) * NWAVES, wave, ln_, (Gk)); __syncthreads(); } } while (0)
#endif
#ifdef CVT_ALL_PRE
#define CVT_POST_G(ILV, W, Kk, Nn, WT, Gk) do { } while (0)
#else
#define CVT_POST_G(ILV, W, Kk, Nn, WT, Gk) do { if (bx & 1) { __syncthreads(); int ln_ = lane; asm volatile("" : "+v"(ln_)); CVT_REPEAT convert_weight_grp<ILV, true>((W), (Kk), (Nn), (WT), lds, 1, (bx >> 1) * NWAVES + wave, (G >> 1) * NWAVES, wave, ln_, (Gk)); } } while (0)
#endif
#endif
    if (IN(0)) REP(0) {
        convert_weight(gmlp_w_in, D, GD, WA, lds, gw, NGW, wave, lane);
#ifdef PROBE_CAB
        { bf16* dummyW = BIG; __syncthreads(); const unsigned long long t0 = __builtin_amdgcn_s_memtime();
          if (CAB_A) cvt_blocks<false, false>(gmlp_w_in, D, GD, dummyW, lds, bx, (D / 64) * (GD / 256), G, tid); else convert_weight<false, 0>(gmlp_w_in, D, GD, dummyW, lds, gw, NGW, wave, lane);
          __syncthreads(); const unsigned long long t1 = __builtin_amdgcn_s_memtime();
          if (CAB_B) cvt_blocks<false, false>(gmlp_w_in, D, GD, dummyW, lds, bx, (D / 64) * (GD / 256), G, tid); else convert_weight<false, 0>(gmlp_w_in, D, GD, dummyW, lds, gw, NGW, wave, lane);
          __syncthreads(); const unsigned long long t2 = __builtin_amdgcn_s_memtime();
          if (tid == 0) { const float dA = (float)(t1 - t0), dB = (float)(t2 - t1); if (dB < dA * (1.0f - (AB_THR))) atomicAdd((unsigned*)(ctl + CW_DBG + 64), 1u); } }
#endif
        first_norm_phase(gw, NGW, lane, x, mix_pre_g, HN);
    }
    SEAM(0);
    PCLK_BEGIN(1);
#ifdef PROBE_EPI1
    if (IN(1)) REP(1) { pg8::Gemm g_{(const pg8::bf16_t*)HN, (const pg8::bf16_t*)WA, M, GD, D}; pg8::StaticOrder S_; S_.init(M, GD, G, bx);
        if (rep_ == 0) { pg8::EpiGeluSplit E{(pg8::bf16_t*)BIG, GH, GH, (size_t)M * GH, (float*)H2, M}; pg8::gemm_phase<pg8::EpiGeluSplit, pg8::StaticOrder, true, true>(lds, g_, S_, E); }
        else if (PROBE_EPI1 == 0) { pg8::EpiNull E; pg8::gemm_phase<pg8::EpiNull, pg8::StaticOrder, true, true>(lds, g_, S_, E); }
        else if (PROBE_EPI1 == 1) { pg8::EpiGeluSplit E{(pg8::bf16_t*)BIG, GH, GH, (size_t)M * GH, (float*)H2, M}; pg8::gemm_phase<pg8::EpiGeluSplit, pg8::StaticOrder, true, true>(lds, g_, S_, E); }
        else { pg8::EpiGeluSplitT<false> E{(pg8::bf16_t*)BIG, GH, GH, (size_t)M * GH, (float*)H2, M}; pg8::gemm_phase<pg8::EpiGeluSplitT<false>, pg8::StaticOrder, true, true>(lds, g_, S_, E); } }
#else
#ifdef PROBE_AB
    if (IN(1)) { int rep_ = 0; (void)rep_;
        CVT_PRE(false, gmlp_w_out, GH, D, WB); pg8::EpiGeluSplit E{(pg8::bf16_t*)BIG, GH, GH, (size_t)M * GH, (float*)H2, M, lds + TAIL_OFF};
        pg8::Gemm g_{(const pg8::bf16_t*)HN, (const pg8::bf16_t*)WA, M, GD, D}; pg8::StaticOrder S_; S_.init(M, GD, G, bx);
        pg8::gemm_phase<pg8::EpiGeluSplit, pg8::StaticOrder, true, KNOB_SP2, KNOB_BAL, 0>(lds, g_, S_, E);
        pg8::EpiNull En; pg8::StaticOrder Sa, Sb; Sa.init(M, GD, G, bx, AB_WGM_A); Sb.init(M, GD, G, bx, AB_WGM_B);
        __syncthreads(); const unsigned long long t0 = AB_CLOCK();
        pg8::gemm_phase<pg8::EpiNull, pg8::StaticOrder, true, KNOB_SP2, true, 0, 0, AB_VAR_A>(lds, g_, Sa, En);
        __syncthreads(); const unsigned long long t1 = AB_CLOCK();
        pg8::gemm_phase<pg8::EpiNull, pg8::StaticOrder, true, KNOB_SP2, true, 0, 0, AB_VAR_B>(lds, g_, Sb, En);
        __syncthreads(); const unsigned long long t2 = AB_CLOCK();
        if (tid == 0) { const float dA = (float)(t1 - t0), dB = (float)(t2 - t1); if (dB < dA * (1.0f - (AB_THR))) atomicAdd((unsigned*)(ctl + CW_DBG + 64), 1u); }
        CVT_POST(false, gmlp_w_out, GH, D, WB); }
#else
    if (IN(1)) REP(1) {
        if (KNOB_GELU_TAB) {
            for (int k = tid; k < pg8::GELU_TAB_N; k += NWAVES * 64) { const float a0 = (float)k * (1.0f / pg8::GELU_TAB_SCALE), a1 = (float)(k + 1) * (1.0f / pg8::GELU_TAB_SCALE);
                const float g0 = 0.5f * a0 * erfcf(a0 * 0.70710678118654752f), g1 = 0.5f * a1 * erfcf(a1 * 0.70710678118654752f);
                ((LAS float*)(lds + TAIL_OFF))[2 * k] = g0; ((LAS float*)(lds + TAIL_OFF))[2 * k + 1] = g1 - g0; }
            __syncthreads(); }
        CVT_PRE(false, gmlp_w_out, GH, D, WB); pg8::EpiGeluSplit E{(pg8::bf16_t*)BIG, GH, GH, (size_t)M * GH, (float*)H2, M, lds + TAIL_OFF}; GEMM(pg8::EpiGeluSplit, HN, WA, GD, D, E); CVT_POST(false, gmlp_w_out, GH, D, WB); }
#endif
#endif
    SEAM(1);
    PCLK_BEGIN(3);
    if (IN(3)) REP(3) {
#ifdef PROBE_GATE
        if (rep_ == 0) gating_phase(lds, vcu, G, tid, BIG, BIG + (size_t)M * GH, (const float*)H2, HN, gmlp_ln_g, gmlp_ln_b, gmlp_w_s, gmlp_b_s); else gating_phase<true>(lds, vcu, G, tid, BIG, BIG + (size_t)M * GH, (const float*)H2, HN, gmlp_ln_g, gmlp_ln_b, gmlp_w_s, gmlp_b_s);
#else
        gating_phase(lds, vcu, G, tid, BIG, BIG + (size_t)M * GH, (const float*)H2, HN, gmlp_ln_g, gmlp_ln_b, gmlp_w_s, gmlp_b_s);
#endif
    }
    SEAM(3);
    PCLK_BEGIN(4);
    if (IN(4)) REP(4) { CVT_PRE_G(true, ffn_w_up, D, FF2, WA, ffn_pre_g); pg8::EpiPlain E{(pg8::bf16_t*)HN, D}; GEMM(pg8::EpiPlain, BIG, WB, D, GH, E); CVT_POST_G(true, ffn_w_up, D, FF2, WA, ffn_pre_g); }
    SEAM(4);
    PCLK_BEGIN(5);
    if (IN(5)) REP(5) {
        resid_fold_phase<true, false>(gw, NGW, lane, HN, x, nullptr, XB, RS, mix_post_g);
    }
    SEAM(5);
    PCLK_BEGIN(6);
#ifdef PROBE_EPI6
    if (IN(6)) REP(6) { if (rep_ == 0) CVT_PRE(false, ffn_w_down, FF, D, WB); pg8::Gemm g_{(const pg8::bf16_t*)HN, (const pg8::bf16_t*)WA, M, FF2, D}; pg8::StaticOrder S_; S_.init(M, FF2, G, bx);
        if (rep_ == 0 || PROBE_EPI6 == 1) { pg8::EpiConvGate E{(pg8::bf16_t*)H2, FF, ffn_conv_w, ffn_conv_b, (float*)BIG, lds + TAIL_OFF, FF2, FF, (LAS float*)(lds + RTAB_OFF)}; pg8::gemm_phase<pg8::EpiConvGate, pg8::StaticOrder, true, true>(lds, g_, S_, E); }
        else { pg8::EpiNull E; pg8::gemm_phase<pg8::EpiNull, pg8::StaticOrder, true, true>(lds, g_, S_, E); }
        if (rep_ == 0) CVT_POST(false, ffn_w_down, FF, D, WB); }
#else
    if (IN(6)) REP(6) { CVT_PRE(false, ffn_w_down, FF, D, WB); pg8::StaticOrder Soe; Soe.init(M, FF2, G, bx); EpiCG E{(pg8::bf16_t*)H2, FF, ffn_conv_w, ffn_conv_b, (float*)BIG, lds + TAIL_OFF, FF2, FF, (LAS float*)(lds + RTAB_OFF), Soe, 0}; GEMM(EpiCG, XB, WA, FF2, D, E); CVT_POST(false, ffn_w_down, FF, D, WB); }
#endif
    SEAM2(6);
    PCLK_BEGIN(8);
    if (IN(8)) REP(8) { { pg8::StaticOrder Sf; Sf.init(M, D, G, bx); pg8::Unit uf; int lastpm = -1; for (int i = 0; Sf.next(i, uf); ++i) if (uf.pm != lastpm) { ffn_fixup_local(tid, uf.pm, -1, (const float*)BIG, H2, ffn_conv_w, ffn_conv_b); lastpm = uf.pm; } }
        CVT_PRE_G(false, ret_w_in, D, RPROJ, WA, mix_pre_g + D); pg8::EpiPlain E{(pg8::bf16_t*)HN, D}; GEMM(pg8::EpiPlain, H2, WB, D, FF, E); CVT_POST_G(false, ret_w_in, D, RPROJ, WA, mix_pre_g + D); }
    SEAM(8);
    PCLK_BEGIN(9);
    if (IN(9)) REP(9) {
        resid_fold_phase<false, false>(gw, NGW, lane, HN, XB, RS, XB, RS, ffn_post_g);
    }
    SEAM(9);
    PCLK_BEGIN(10);
    if (IN(10)) REP(10) { CVT_PRE(false, ret_w_out, RV, D, WB); pg8::EpiRetIn E{(pg8::bf16_t*)BIG, M, positions}; GEMM(pg8::EpiRetIn, XB, WA, RPROJ, D, E); CVT_POST(false, ret_w_out, RV, D, WB); }
    SEAM(10);
    PCLK_BEGIN(11);
    if (IN(11)) REP(11) {
#ifdef PROBE_RAB
        { unsigned long long ta = 0, tb = 0;
          _Pragma("unroll 1") for (int r2 = 0; r2 < 2; ++r2) { int fl = r2 ? (int)(RAB_B) : (int)(RAB_A); asm volatile("" : "+s"(fl));
              __syncthreads(); const unsigned long long tq = AB_CLOCK(); if (r2 == 0) ta = tq; else tb = tq;
              retention_phase<true, true, false>(lds, vcu, G, tid, BIG, H2, (float*)(H2 + (size_t)M * RV), nullptr, fl != 0); }
          __syncthreads(); const unsigned long long tc = AB_CLOCK();
          if (tid == 0) { const float dA = (float)(tb - ta), dB = (float)(tc - tb); if (dB < dA * (1.0f - (AB_THR))) atomicAdd((unsigned*)(ctl + CW_DBG + 64), 1u); } }
#elif defined(PROBE_RET)
        if (rep_ == 0) retention_phase(lds, vcu, G, tid, BIG, H2, (float*)(H2 + (size_t)M * RV)); else retention_phase<false, (PROBE_RET & 1) != 0>(lds, vcu, G, tid, BIG, H2, (float*)(H2 + (size_t)M * RV));
#else
        retention_phase(lds, vcu, G, tid, BIG, H2, (float*)(H2 + (size_t)M * RV));
#endif
    }
    SEAM(11);
    PCLK_BEGIN(13);
    if (IN(13)) REP(13) { { pg8::StaticOrder Sf; Sf.init(M, D, G, bx); pg8::Unit ua, ub; ub.pm = -1; Sf.next(0, ua); if (!Sf.next(1, ub)) ub.pm = -1; ret_scale_table((LAS float*)(lds + RTAB_OFF), tid, ua.pm, ub.pm, (const float*)(H2 + (size_t)M * RV)); }
        CVT_PRE_G(true, ffn_w_up + (size_t)D * FF2, D, FF2, WA, ffn_pre_g + D); pg8::EpiPlainKS E{(pg8::bf16_t*)HN, D, (const LAS float*)(lds + RTAB_OFF)}; GEMM(pg8::EpiPlainKS, H2, WB, D, RV, E); CVT_POST_G(true, ffn_w_up + (size_t)D * FF2, D, FF2, WA, ffn_pre_g + D); }
    SEAM(13);
    PCLK_BEGIN(14);
    if (IN(14)) REP(14) {
        resid_fold_phase<false, false>(gw, NGW, lane, HN, XB, RS, XB3, RS, mix_post_g + D);
    }
    SEAM(14);
    PCLK_BEGIN(15);
    if (IN(15)) REP(15) { CVT_PRE(false, ffn_w_down + (size_t)FF * D, FF, D, WB); pg8::StaticOrder Soe; Soe.init(M, FF2, G, bx); EpiCG E{(pg8::bf16_t*)H2, FF, ffn_conv_w + (size_t)3 * FF2, ffn_conv_b + FF2, (float*)BIG, lds + TAIL_OFF, FF2, FF, (LAS float*)(lds + RTAB_OFF), Soe, 0}; GEMM(EpiCG, XB3, WA, FF2, D, E); CVT_POST(false, ffn_w_down + (size_t)FF * D, FF, D, WB); }
    SEAM2(15);
    PCLK_BEGIN(17);
    if (IN(17)) REP(17) { { pg8::StaticOrder Sf; Sf.init(M, D, G, bx); pg8::Unit uf; int lastpm = -1; for (int i = 0; Sf.next(i, uf); ++i) if (uf.pm != lastpm) { ffn_fixup_local(tid, uf.pm, -1, (const float*)BIG, H2, ffn_conv_w + (size_t)3 * FF2, ffn_conv_b + FF2); lastpm = uf.pm; } }
        pg8::EpiPlain E{(pg8::bf16_t*)HN, D}; GEMM(pg8::EpiPlain, H2, WB, D, FF, E); }
    SEAM(17);
    PCLK_BEGIN(18);
    if (IN(18)) REP(18) { resid_fold_phase<false, true>(gw, NGW, lane, HN, XB3, RS, out, nullptr, ffn_post_g + D); }
#if defined(PROBE_AB) || defined(PROBE_RAB) || defined(PROBE_CAB)
    { xcd_barrier(bar); const unsigned votes = __hip_atomic_load((unsigned*)(ctl + CW_DBG + 64), __ATOMIC_RELAXED, __HIP_MEMORY_SCOPE_AGENT); const float sc = (votes * 2u > (unsigned)G) ? 1.5f : 1.0f;
      for (int m = gw; m < M; m += NGW) { GAS f32x4* xo = (GAS f32x4*)(out + (size_t)m * D); for (int j = lane; j < D / 4; j += 64) { f32x4 v = xo[j]; v = v * sc; xo[j] = v; } } }
#endif
#ifdef PROBE_CLOCK
    { const float sc = 1.0f + 0.1f * __hip_atomic_load((float*)(ctl + CW_DBG), __ATOMIC_RELAXED, __HIP_MEMORY_SCOPE_AGENT); asm volatile("s_waitcnt vmcnt(0)" ::: "memory");
      for (int m = gw; m < M; m += NGW) { GAS f32x4* xo = (GAS f32x4*)(out + (size_t)m * D); for (int j = lane; j < D / 4; j += 64) { f32x4 v = xo[j]; v = v * sc; xo[j] = v; } } }
#endif
#undef IN
#undef SEAM
#undef GEMM
}

extern "C" void kernel_launch(void* const* d_in, const int* in_sizes, int n_in, void* d_out, int out_size, void* d_ws, size_t ws_size, hipStream_t stream) {
    static int grid = 0;
    if (grid == 0) {
        if (n_in != 18 || in_sizes[0] != M * D || out_size != M * D || ws_size < WS_END) { fprintf(stderr, "kernel_launch: unexpected problem shape / workspace (n_in %d, in0 %d, out %d, ws %zu < %zu)\n", n_in, n_in > 0 ? in_sizes[0] : -1, out_size, ws_size, (size_t)WS_END); grid = -1; return; }
        int dev = 0, cus = 0, per_cu = 0;
        if (hipGetDevice(&dev) != hipSuccess || hipDeviceGetAttribute(&cus, hipDeviceAttributeMultiprocessorCount, dev) != hipSuccess) { fprintf(stderr, "kernel_launch: device query failed\n"); grid = -1; return; }
        if (hipFuncSetAttribute((const void*)mega_fwd, hipFuncAttributeMaxDynamicSharedMemorySize, LDS_BYTES) != hipSuccess) { fprintf(stderr, "kernel_launch: hipFuncSetAttribute failed\n"); grid = -1; return; }
        if (hipOccupancyMaxActiveBlocksPerMultiprocessor(&per_cu, (const void*)mega_fwd, NWAVES * 64, LDS_BYTES) != hipSuccess || per_cu < 1) fprintf(stderr, "kernel_launch: note: occupancy query reports %d workgroups per CU\n", per_cu);
        (void)hipGetLastError();
        grid = cus;
    }
    if (grid < 0) return;
    if (hipMemsetAsync((char*)d_ws, 0, ZERO_BYTES, stream) != hipSuccess) { fprintf(stderr, "kernel_launch: memset failed\n"); return; }
    Args a{};
    for (int i = 0; i < 18; ++i) a.in[i] = d_in[i];
    a.out = (float*)d_out; a.ws = (unsigned char*)d_ws; a.ph_lo = 0; a.ph_hi = N_PHASES;
    hipLaunchKernelGGL(mega_fwd, dim3(grid), dim3(NWAVES * 64), LDS_BYTES, stream, a);
    const hipError_t le = hipPeekAtLastError();
    if (le != hipSuccess) fprintf(stderr, "kernel_launch: launch failed: %s\n", hipGetErrorName(le));
}
```

```cpp
#include <hip/hip_runtime.h>
#include <cstdio>
#include <cstdint>
#define KNOB_BAL true
#define CVT_NT_LOADS 1
#define X_NT_LOADS 1
#define CVT_STAG 1
namespace pg8 {
#define PG8_LAS __attribute__((address_space(3)))
typedef unsigned short bf16_t;
typedef short bf16x8 __attribute__((ext_vector_type(8)));
typedef float f32x4 __attribute__((ext_vector_type(4)));
typedef unsigned u32x4 __attribute__((ext_vector_type(4)));
constexpr int BM = 256, BK = 64, HALF = 128, HTB = HALF * BK * 2  , STAGE_BYTES = 8 * HTB, NXCD = 8, WGM = 8;

__host__ __device__ __forceinline__ int lds_byte(int r, int c) { const int st = (r >> 4) * 2 + (c >> 5), rr = r & 15, cc = c & 31, ob = rr * 64 + cc * 2; return st * 1024 + (ob ^ (((ob >> 9) & 1) << 5)); }
__host__ __device__ __forceinline__ void stage_rc(int b, int& R, int& C) { const int st = b / 1024, sb = b % 1024, swz = sb ^ (((sb >> 9) & 1) << 5); R = (st >> 1) * 16 + swz / 64; C = (st & 1) * 32 + (swz % 64) / 2; }
__host__ __device__ __forceinline__ int perm32(int rho) { const int n = rho >> 4, i = rho & 15; return 8 * (i >> 2) + 4 * n + (i & 3); }

struct Unit { int pm, pn; };
struct Gemm { const bf16_t* A; const bf16_t* Bt; int M, N, K; };

struct StaticOrder {
    int nM, nN, nwg, G, c, wgm;
    __host__ __device__ void init(int M, int N, int G_, int c_, int wgm_ = WGM) { nM = M / BM; nN = N / BM; nwg = nM * nN; G = G_; c = c_; wgm = wgm_; }
    __host__ __device__ __forceinline__ bool next(int i, Unit& u) const {
        const long L = (long)i * G + c; if (L >= nwg) return false;
        int wgid = (int)L; { const int q = nwg / NXCD, r = nwg % NXCD, xcd = wgid % NXCD, off = wgid / NXCD; wgid = (xcd < r ? xcd * (q + 1) : r * (q + 1) + (xcd - r) * q) + off; }
        const int nig = wgm * nN, gid = wgid / nig, fm = gid * wgm, gsz = (nM - fm) < wgm ? (nM - fm) : wgm;
        u.pm = fm + ((wgid % nig) % gsz); u.pn = (wgid % nig) / gsz; return true;
    }
    __device__ __forceinline__ void a_ready(const Unit&) const {}
    __device__ __forceinline__ void done(const Unit&) const {}
};

__device__ __forceinline__ unsigned cvt_pk_bf16(float lo, float hi) { unsigned r; asm volatile("v_cvt_pk_bf16_f32 %0, %1, %2" : "=v"(r) : "v"(lo), "v"(hi)); return r; }
typedef float f32x2 __attribute__((ext_vector_type(2)));
__device__ __forceinline__ f32x2 gelu_pk(f32x2 v) {
    f32x2 a; a.x = __builtin_amdgcn_fmed3f(__builtin_fabsf(v.x), 0.f, 6.0f); a.y = __builtin_amdgcn_fmed3f(__builtin_fabsf(v.y), 0.f, 6.0f);
    f32x2 p = a * 3.309384555905126e-05f + (-0.0007692287326790392f); p = p * a + 0.008080746047198772f; p = p * a + (-0.05341215059161186f); p = p * a + (-0.4587709307670593f);
    p = p * a + (-1.1512017250061035f); p = p * a + (-0.999993085861206f);
    f32x2 t; t.x = __builtin_amdgcn_exp2f(p.x); t.y = __builtin_amdgcn_exp2f(p.y);
    f32x2 sm; sm.x = v.x + __builtin_fabsf(v.x); sm.y = v.y + __builtin_fabsf(v.y);
    return sm * 0.5f - a * t;
}

__device__ __forceinline__ void gelu_pk4(f32x2 (&v)[4]) {
    f32x2 a[4], p[4], t[4];
#pragma unroll
    for (int i = 0; i < 4; ++i) { a[i].x = __builtin_amdgcn_fmed3f(__builtin_fabsf(v[i].x), 0.f, 6.0f); a[i].y = __builtin_amdgcn_fmed3f(__builtin_fabsf(v[i].y), 0.f, 6.0f); }
#pragma unroll
    for (int i = 0; i < 4; ++i) p[i] = a[i] * 3.309384555905126e-05f + (-0.0007692287326790392f);
    asm volatile("" : "+v"(p[0]), "+v"(p[1]), "+v"(p[2]), "+v"(p[3]));
#pragma unroll
    for (int i = 0; i < 4; ++i) p[i] = p[i] * a[i] + 0.008080746047198772f;
    asm volatile("" : "+v"(p[0]), "+v"(p[1]), "+v"(p[2]), "+v"(p[3]));
#pragma unroll
    for (int i = 0; i < 4; ++i) p[i] = p[i] * a[i] + (-0.05341215059161186f);
    asm volatile("" : "+v"(p[0]), "+v"(p[1]), "+v"(p[2]), "+v"(p[3]));
#pragma unroll
    for (int i = 0; i < 4; ++i) p[i] = p[i] * a[i] + (-0.4587709307670593f);
    asm volatile("" : "+v"(p[0]), "+v"(p[1]), "+v"(p[2]), "+v"(p[3]));
#pragma unroll
    for (int i = 0; i < 4; ++i) p[i] = p[i] * a[i] + (-1.1512017250061035f);
    asm volatile("" : "+v"(p[0]), "+v"(p[1]), "+v"(p[2]), "+v"(p[3]));
#pragma unroll
    for (int i = 0; i < 4; ++i) p[i] = p[i] * a[i] + (-0.999993085861206f);
    asm volatile("" : "+v"(p[0]), "+v"(p[1]), "+v"(p[2]), "+v"(p[3]));
#pragma unroll
    for (int i = 0; i < 4; ++i) { t[i].x = __builtin_amdgcn_exp2f(p[i].x); t[i].y = __builtin_amdgcn_exp2f(p[i].y); }
    asm volatile("" : "+v"(t[0]), "+v"(t[1]), "+v"(t[2]), "+v"(t[3]));
#pragma unroll
    for (int i = 0; i < 4; ++i) { f32x2 sm; sm.x = v[i].x + __builtin_fabsf(v[i].x); sm.y = v[i].y + __builtin_fabsf(v[i].y); v[i] = sm * 0.5f - a[i] * t[i]; }
}

template <int ACT  > struct EpiBf16 {
    static constexpr bool PERM = true, AFTER_DRAIN = false; static_assert(ACT == 0 || ACT == 1, "EpiBf16: ACT is 0 (none) or 1 (gelu_pk)");
    bf16_t* O; int ldc; const float* bias; int split_cols; size_t split_stride; float scale0;
    __device__ __forceinline__ void operator()(const f32x4 (&acc)[2][2][4][2], const Unit& u, int wr, int wc, int fr, int fq) const {
        const int row0 = u.pm * BM + wr * 64 + fr; int colt = u.pn * BM; bf16_t* base = O;
        float sc = 1.f; if (split_cols) { const int t = colt / split_cols; base += (size_t)t * split_stride; colt -= t * split_cols; if (t == 0) sc = scale0; }
        const int col0 = colt + wc * 32 + 8 * fq, bcol0 = u.pn * BM + wc * 32 + 8 * fq;
        f32x4 bv[2][2];
#pragma unroll
        for (int bj = 0; bj < 2; ++bj)
#pragma unroll
            for (int n = 0; n < 2; ++n) bv[bj][n] = bias ? *(const f32x4*)(bias + bcol0 + bj * HALF + 4 * n) : (f32x4){0.f, 0.f, 0.f, 0.f};
#pragma unroll
        for (int ai = 0; ai < 2; ++ai)
#pragma unroll
            for (int m = 0; m < 4; ++m) { bf16_t* rowp = base + (size_t)(row0 + ai * HALF + m * 16) * ldc + col0;
#pragma unroll
                for (int bj = 0; bj < 2; ++bj) { f32x4 v0 = acc[ai][bj][m][0] + bv[bj][0], v1 = acc[ai][bj][m][1] + bv[bj][1];
                    if (ACT == 1) { f32x2 a = gelu_pk((f32x2){v0[0], v0[1]}), b = gelu_pk((f32x2){v0[2], v0[3]}), c = gelu_pk((f32x2){v1[0], v1[1]}), d = gelu_pk((f32x2){v1[2], v1[3]});
                        v0 = (f32x4){a.x, a.y, b.x, b.y}; v1 = (f32x4){c.x, c.y, d.x, d.y}; }
                    v0 = v0 * sc; v1 = v1 * sc; u32x4 w; w.x = cvt_pk_bf16(v0[0], v0[1]); w.y = cvt_pk_bf16(v0[2], v0[3]); w.z = cvt_pk_bf16(v1[0], v1[1]); w.w = cvt_pk_bf16(v1[2], v1[3]);
                    *(u32x4*)(rowp + bj * HALF) = w; } }
    }
};
template <class T, class = void> struct HasKScale { static constexpr bool value = false; };
template <class T> struct HasKScale<T, decltype((void)T::KSCALE)> { static constexpr bool value = T::KSCALE; };
template <class T, class = void> struct HasRowScale { static constexpr bool value = false; };
template <class T> struct HasRowScale<T, decltype((void)T::ROWSCALE)> { static constexpr bool value = T::ROWSCALE; };
template <class T, class = void> struct HasAPerm4 { static constexpr bool value = false; };
template <class T> struct HasAPerm4<T, decltype((void)T::APERM4)> { static constexpr bool value = T::APERM4; };
template <class Epi, class Sched, bool ALIGN_EPI = false, bool SP2 = false, bool BAL = false, int EB = 0, int DIAG = 0, int VAR = 0>
__device__ __forceinline__ void gemm_phase(PG8_LAS unsigned char* lds, const Gemm g, const Sched& S, const Epi& E) {
    const int tid = threadIdx.x, wid = __builtin_amdgcn_readfirstlane(tid >> 6), lane = tid & 63, wr = wid >> 2, wc = wid & 3, fr = lane & 15, fq = lane >> 4;
    const int K = g.K, nt = K / BK;
    unsigned voffA[2], voffB[2];
#pragma unroll
    for (int i = 0; i < 2; ++i) { int R, C; stage_rc(tid * 16 + i * 8192, R, C); const int Rb = Epi::PERM ? ((R & ~31) + perm32(R & 31)) : R;
        const int Ra = HasAPerm4<Epi>::value ? ((R & 64) + 4 * (R & 15) + ((R >> 4) & 3)) : R;
        voffA[i] = (unsigned)(Ra * K + C) * 2u; voffB[i] = (unsigned)(Rb * K + C) * 2u; }
    const size_t kstep = (size_t)(BK * 2);
    const size_t hstep = (size_t)HALF * K * 2;
    const size_t tstep = 2 * hstep;
    const unsigned ldsw = (unsigned)wid * 1024u;
    const int aoff = lds_byte(wr * 64 + fr, fq * 8), boff = lds_byte(wc * 32 + fr, fq * 8);
#define PG8_SA(b, h) (((b) * 2 + (h)) * HTB)
#define PG8_SB(b, h) ((4 + (b) * 2 + (h)) * HTB)
#define PG8_STAGEX(aux, bufoff, gbase, voff) do { if constexpr (DIAG != 3) _Pragma("unroll") for (int _i = 0; _i < 2; ++_i) \
        __builtin_amdgcn_global_load_lds((const unsigned*)((const char*)(gbase) + (voff)[_i]), (PG8_LAS unsigned*)(lds + (bufoff) + ldsw + _i * 8192), 16, 0, (aux)); } while (0)
    constexpr int AUXA = (VAR & 32) ? 2 : 0, AUXB = (VAR & 16) ? 2 : 0;
#define PG8_LDA(dst, b, h) do { if (DIAG != 2 || never_) _Pragma("unroll") for (int m = 0; m < 4; ++m) _Pragma("unroll") for (int k = 0; k < 2; ++k) dst[m][k] = *(const PG8_LAS bf16x8*)(lds + PG8_SA(b, h) + aoff + m * 2048 + k * 1024); } while (0)
#define PG8_LDB(dst, b, h) do { if (DIAG != 2 || never_) _Pragma("unroll") for (int n = 0; n < 2; ++n) _Pragma("unroll") for (int k = 0; k < 2; ++k) dst[n][k] = *(const PG8_LAS bf16x8*)(lds + PG8_SB(b, h) + boff + n * 2048 + k * 1024); } while (0)
#define PG8_MMA(ai, bj, At, Bt) do { if constexpr (!(VAR & 1)) __builtin_amdgcn_s_setprio((VAR & 8) ? 3 : 1); _Pragma("unroll") for (int m = 0; m < 4; ++m) _Pragma("unroll") for (int n = 0; n < 2; ++n) _Pragma("unroll") for (int k = 0; k < 2; ++k) \
        acc[ai][bj][m][n] = __builtin_amdgcn_mfma_f32_16x16x32_bf16(Bt[n][k], At[m][k], acc[ai][bj][m][n], 0, 0, 0); if constexpr (!(VAR & 1)) __builtin_amdgcn_s_setprio(0); } while (0)
#define PG8_MMA_R(ai, bj, At, Bt, m0, m1) do { __builtin_amdgcn_s_setprio(1); _Pragma("unroll") for (int m = (m0); m < (m1); ++m) _Pragma("unroll") for (int n = 0; n < 2; ++n) _Pragma("unroll") for (int k = 0; k < 2; ++k) \
        acc[ai][bj][m][n] = __builtin_amdgcn_mfma_f32_16x16x32_bf16(Bt[n][k], At[m][k], acc[ai][bj][m][n], 0, 0, 0); __builtin_amdgcn_s_setprio(0); } while (0)
#define PG8_MMA_T(ai, bj, At, Bt, m0, m1) do { _Pragma("unroll") for (int m = (m0); m < (m1); ++m) _Pragma("unroll") for (int n = 0; n < 2; ++n) _Pragma("unroll") for (int k = 0; k < 2; ++k) \
        acc[ai][bj][m][n] = __builtin_amdgcn_mfma_f32_16x16x32_bf16(Bt[n][k], At[m][k], acc[ai][bj][m][n], 0, 0, 0); __builtin_amdgcn_s_setprio(0); } while (0)
#define PG8_MMA2_BAR(ai, At) do { if constexpr (EB == 0) { PG8_MMA(ai, 0, At, B0); PG8_MMA(ai, 1, At, B1); PG8_BAR; } \
        else { PG8_MMA(ai, 0, At, B0); PG8_MMA_R(ai, 1, At, B1, 0, 4 - EB); __builtin_amdgcn_s_setprio(3); PG8_SCHED; PG8_BAR; PG8_SCHED; PG8_MMA_T(ai, 1, At, B1, 4 - EB, 4); } } while (0)
#define PG8_WAIT_V(n) asm volatile("s_waitcnt vmcnt(" #n ")" ::: "memory")
#define PG8_WAIT_L(n) asm volatile("s_waitcnt lgkmcnt(" #n ")" ::: "memory")
#define PG8_BAR __builtin_amdgcn_s_barrier()
#define PG8_WLB(n) do { PG8_WAIT_V(n); if constexpr (VAR & 4) { PG8_BAR; PG8_WAIT_L(0); } else { PG8_WAIT_L(0); PG8_BAR; } } while (0)
#define PG8_SCHED __builtin_amdgcn_sched_barrier(0)
    Unit cur, nxt; int ui = 0;
    if (!S.next(0, cur)) return;
    f32x4 acc[2][2][4][2];
#pragma unroll
    for (int a = 0; a < 2; ++a)
#pragma unroll
        for (int b = 0; b < 2; ++b)
#pragma unroll
            for (int m = 0; m < 4; ++m)
#pragma unroll
                for (int n = 0; n < 2; ++n) acc[a][b][m][n] = (f32x4){0.f, 0.f, 0.f, 0.f};
    bf16x8 At[4][2], B0[2][2], B1[2][2];
    int never_ = 0; if constexpr (DIAG == 2) { asm volatile("" : "+s"(never_));
        _Pragma("unroll") for (int m = 0; m < 4; ++m) _Pragma("unroll") for (int k = 0; k < 2; ++k) At[m][k] = (bf16x8){0, 0, 0, 0, 0, 0, 0, 0};
        _Pragma("unroll") for (int n = 0; n < 2; ++n) _Pragma("unroll") for (int k = 0; k < 2; ++k) { B0[n][k] = (bf16x8){0, 0, 0, 0, 0, 0, 0, 0}; B1[n][k] = (bf16x8){0, 0, 0, 0, 0, 0, 0, 0}; } }
    const char* cA = (const char*)g.A + (size_t)(DIAG == 1 ? 0 : cur.pm) * tstep; const char* cB = (const char*)g.Bt + (size_t)(DIAG == 1 ? 0 : cur.pn) * tstep;
    S.a_ready(cur);
    if constexpr (SP2 && BAL) {
        PG8_STAGEX(AUXB, PG8_SB(0, 0), cB, voffB); PG8_STAGEX(AUXB, PG8_SB(0, 1), cB + hstep, voffB); PG8_STAGEX(AUXA, PG8_SA(0, 0), cA, voffA); PG8_STAGEX(AUXA, PG8_SA(0, 1), cA + hstep, voffA);
        if (wr == 1) PG8_BAR;
        PG8_WAIT_V(2); PG8_BAR;
        PG8_STAGEX(AUXB, PG8_SB(1, 0), cB + kstep, voffB); PG8_STAGEX(AUXB, PG8_SB(1, 1), cB + hstep + kstep, voffB);
        PG8_WAIT_V(4); PG8_BAR;
    } else if constexpr (SP2) {
        PG8_STAGEX(AUXB, PG8_SB(0, 0), cB, voffB); PG8_STAGEX(AUXB, PG8_SB(0, 1), cB + hstep, voffB); PG8_STAGEX(AUXA, PG8_SA(0, 0), cA, voffA); PG8_STAGEX(AUXA, PG8_SA(0, 1), cA + hstep, voffA);
        if (wr == 1) PG8_BAR;
        PG8_WAIT_V(2); PG8_BAR;
        PG8_STAGEX(AUXB, PG8_SB(1, 0), cB + kstep, voffB); PG8_STAGEX(AUXA, PG8_SA(1, 0), cA + kstep, voffA); PG8_STAGEX(AUXB, PG8_SB(1, 1), cB + hstep + kstep, voffB);
        PG8_WAIT_V(6); PG8_BAR;
    } else {
        PG8_STAGEX(AUXB, PG8_SB(0, 0), cB, voffB); PG8_STAGEX(AUXA, PG8_SA(0, 0), cA, voffA); PG8_STAGEX(AUXB, PG8_SB(0, 1), cB + hstep, voffB); PG8_STAGEX(AUXA, PG8_SA(0, 1), cA + hstep, voffA);
        if (wr == 1) PG8_BAR;
        PG8_WAIT_V(4); PG8_BAR;
        PG8_STAGEX(AUXB, PG8_SB(1, 0), cB + kstep, voffB); PG8_STAGEX(AUXA, PG8_SA(1, 0), cA + kstep, voffA); PG8_STAGEX(AUXB, PG8_SB(1, 1), cB + hstep + kstep, voffB);
        PG8_WAIT_V(6); PG8_BAR;
    }
    for (;;) {
        const bool has_next = S.next(ui + 1, nxt);
        const char* nA = has_next ? (const char*)g.A + (size_t)(DIAG == 1 ? 0 : nxt.pm) * tstep : cA; const char* nB = has_next ? (const char*)g.Bt + (size_t)(DIAG == 1 ? 0 : nxt.pn) * tstep : cB;
        for (int t = 0; t < nt; t += 2) {
            const bool last = (t == nt - 2);
            const char* a1 = cA + (size_t)(t + 1) * kstep;
            const char* a2 = last ? nA : cA + (size_t)(t + 2) * kstep; const char* b2 = last ? nB : cB + (size_t)(t + 2) * kstep;
            const char* a3 = a2 + kstep; const char* b3 = b2 + kstep;
            if (last && has_next) S.a_ready(nxt);
            if constexpr (SP2 && BAL) {
            if constexpr (VAR & 2) { PG8_STAGEX(AUXA, PG8_SA(1, 0), a1, voffA); PG8_STAGEX(AUXA, PG8_SA(1, 1), a1 + hstep, voffA); PG8_SCHED; } PG8_LDB(B0, 0, 0); PG8_LDB(B1, 0, 1); PG8_SCHED; PG8_LDA(At, 0, 0); if constexpr (!(VAR & 2)) { PG8_STAGEX(AUXA, PG8_SA(1, 0), a1, voffA); PG8_STAGEX(AUXA, PG8_SA(1, 1), a1 + hstep, voffA); }
            PG8_WLB(8); PG8_MMA2_BAR(0, At); PG8_SCHED;
            if constexpr (VAR & 2) { PG8_STAGEX(AUXB, PG8_SB(0, 0), b2, voffB); PG8_STAGEX(AUXB, PG8_SB(0, 1), b2 + hstep, voffB); PG8_SCHED; } PG8_LDA(At, 0, 1); if constexpr (!(VAR & 2)) { PG8_STAGEX(AUXB, PG8_SB(0, 0), b2, voffB); PG8_STAGEX(AUXB, PG8_SB(0, 1), b2 + hstep, voffB); }
            PG8_WLB(6); PG8_MMA2_BAR(1, At); PG8_SCHED;
            if constexpr (VAR & 2) { PG8_STAGEX(AUXA, PG8_SA(0, 0), a2, voffA); PG8_STAGEX(AUXA, PG8_SA(0, 1), a2 + hstep, voffA); PG8_SCHED; } PG8_LDB(B0, 1, 0); PG8_LDB(B1, 1, 1); PG8_SCHED; PG8_LDA(At, 1, 0); if constexpr (!(VAR & 2)) { PG8_STAGEX(AUXA, PG8_SA(0, 0), a2, voffA); PG8_STAGEX(AUXA, PG8_SA(0, 1), a2 + hstep, voffA); }
            PG8_WLB(8); PG8_MMA2_BAR(0, At); PG8_SCHED;
            if constexpr (VAR & 2) { PG8_STAGEX(AUXB, PG8_SB(1, 0), b3, voffB); PG8_STAGEX(AUXB, PG8_SB(1, 1), b3 + hstep, voffB); PG8_SCHED; } PG8_LDA(At, 1, 1); if constexpr (!(VAR & 2)) { PG8_STAGEX(AUXB, PG8_SB(1, 0), b3, voffB); PG8_STAGEX(AUXB, PG8_SB(1, 1), b3 + hstep, voffB); }
            PG8_WLB(6); PG8_MMA2_BAR(1, At); PG8_SCHED;
            if constexpr (HasKScale<Epi>::value) { if (((t + 2) & 7) == 0) { E.kscale(acc, ui, (t + 2) / 8 - 1, wr, fr); PG8_SCHED; } }
            (void)a3;
            } else if constexpr (SP2) {
            PG8_LDB(B0, 0, 0); PG8_LDB(B1, 0, 1); PG8_SCHED; PG8_LDA(At, 0, 0); PG8_STAGEX(AUXA, PG8_SA(1, 1), a1 + hstep, voffA);
            PG8_WAIT_V(8); PG8_WAIT_L(0); PG8_BAR; PG8_MMA(0, 0, At, B0); PG8_MMA(0, 1, At, B1); PG8_BAR; PG8_SCHED;
            PG8_LDA(At, 0, 1); PG8_STAGEX(AUXB, PG8_SB(0, 0), b2, voffB); PG8_STAGEX(AUXB, PG8_SB(0, 1), b2 + hstep, voffB); PG8_STAGEX(AUXA, PG8_SA(0, 0), a2, voffA);
            PG8_WAIT_V(8); PG8_WAIT_L(0); PG8_BAR; PG8_MMA(1, 0, At, B0); PG8_MMA(1, 1, At, B1); PG8_BAR; PG8_SCHED;
            PG8_LDB(B0, 1, 0); PG8_LDB(B1, 1, 1); PG8_SCHED; PG8_LDA(At, 1, 0); PG8_STAGEX(AUXA, PG8_SA(0, 1), a2 + hstep, voffA);
            PG8_WAIT_V(8); PG8_WAIT_L(0); PG8_BAR; PG8_MMA(0, 0, At, B0); PG8_MMA(0, 1, At, B1); PG8_BAR; PG8_SCHED;
            PG8_LDA(At, 1, 1); PG8_STAGEX(AUXB, PG8_SB(1, 0), b3, voffB); PG8_STAGEX(AUXB, PG8_SB(1, 1), b3 + hstep, voffB); PG8_STAGEX(AUXA, PG8_SA(1, 0), a3, voffA);
            PG8_WAIT_V(8); PG8_WAIT_L(0); PG8_BAR; PG8_MMA(1, 0, At, B0); PG8_MMA(1, 1, At, B1); PG8_BAR; PG8_SCHED;
            if constexpr (HasKScale<Epi>::value) { if (((t + 2) & 7) == 0) { E.kscale(acc, ui, (t + 2) / 8 - 1, wr, fr); PG8_SCHED; } }
            } else {
            PG8_LDB(B0, 0, 0); PG8_SCHED; PG8_LDA(At, 0, 0); PG8_STAGEX(AUXA, PG8_SA(1, 1), a1 + hstep, voffA);
            PG8_WAIT_L(8); PG8_BAR; PG8_WAIT_L(0); PG8_MMA(0, 0, At, B0); PG8_BAR; PG8_SCHED;
            PG8_LDB(B1, 0, 1); PG8_STAGEX(AUXB, PG8_SB(0, 0), b2, voffB);
            PG8_BAR; PG8_WAIT_L(0); PG8_MMA(0, 1, At, B1); PG8_BAR;
            PG8_LDA(At, 0, 1); PG8_STAGEX(AUXA, PG8_SA(0, 0), a2, voffA);
            PG8_BAR; PG8_WAIT_L(0); PG8_MMA(1, 0, At, B0); PG8_BAR; PG8_SCHED;
            PG8_STAGEX(AUXB, PG8_SB(0, 1), b2 + hstep, voffB);
            PG8_WAIT_V(6); PG8_BAR; PG8_MMA(1, 1, At, B1); PG8_BAR;
            PG8_LDB(B0, 1, 0); PG8_SCHED; PG8_LDA(At, 1, 0); PG8_STAGEX(AUXA, PG8_SA(0, 1), a2 + hstep, voffA);
            PG8_WAIT_L(8); PG8_BAR; PG8_WAIT_L(0); PG8_MMA(0, 0, At, B0); PG8_BAR; PG8_SCHED;
            PG8_LDB(B1, 1, 1); PG8_STAGEX(AUXB, PG8_SB(1, 0), b3, voffB);
            PG8_BAR; PG8_WAIT_L(0); PG8_MMA(0, 1, At, B1); PG8_BAR;
            PG8_LDA(At, 1, 1); PG8_STAGEX(AUXA, PG8_SA(1, 0), a3, voffA);
            PG8_BAR; PG8_WAIT_L(0); PG8_MMA(1, 0, At, B0); PG8_BAR; PG8_SCHED;
            PG8_STAGEX(AUXB, PG8_SB(1, 1), b3 + hstep, voffB);
            PG8_WAIT_V(6); PG8_BAR; PG8_MMA(1, 1, At, B1); PG8_BAR;
            }
        }
        if constexpr (ALIGN_EPI) { if (wr == 0) PG8_BAR; }
        if constexpr (HasRowScale<Epi>::value) E.prescale(acc, cur, wr, fr);
        if constexpr (!Epi::AFTER_DRAIN) { E(acc, cur, wr, wc, fr, fq); S.done(cur); }
        if (!has_next) break;
#pragma unroll
        for (int a = 0; a < 2; ++a)
#pragma unroll
            for (int b = 0; b < 2; ++b)
#pragma unroll
                for (int m = 0; m < 4; ++m)
#pragma unroll
                    for (int n = 0; n < 2; ++n) acc[a][b][m][n] = (f32x4){0.f, 0.f, 0.f, 0.f};
        cur = nxt; cA = nA; cB = nB; ++ui;
        if constexpr (ALIGN_EPI) { if (wr == 1) PG8_BAR; }
    }
    PG8_WAIT_V(0);
    if constexpr (!ALIGN_EPI) { if (wr == 0) PG8_BAR; }
    PG8_BAR;
    if constexpr (Epi::AFTER_DRAIN) { E.fused(acc, cur, wr, wc, fr, fq, lds, wid, lane); S.done(cur); }
#undef PG8_SA
#undef PG8_SB
#undef PG8_STAGEX
#undef PG8_LDA
#undef PG8_LDB
#undef PG8_MMA
#undef PG8_MMA_R
#undef PG8_WLB
#undef PG8_MMA_T
#undef PG8_MMA2_BAR
#undef PG8_WAIT_V
#undef PG8_WAIT_L
#undef PG8_BAR
#undef PG8_SCHED
}
}
namespace pg8 {
typedef float f32x2e __attribute__((ext_vector_type(2))); typedef __bf16 bf16x2e __attribute__((ext_vector_type(2)));
__device__ __forceinline__ float sum_fq(float v) {
    v += __builtin_bit_cast(float, __builtin_amdgcn_ds_swizzle(__builtin_bit_cast(int, v), 0x401F));
    const int idx = (int)(((threadIdx.x & 63u) ^ 32u) << 2);
    return v + __builtin_bit_cast(float, __builtin_amdgcn_ds_bpermute(idx, __builtin_bit_cast(int, v))); }
__device__ __forceinline__ unsigned pk_bf16(float lo, float hi) { f32x2e v = {lo, hi}; bf16x2e b = __builtin_convertvector(v, bf16x2e); return __builtin_bit_cast(unsigned, b); }
__device__ __forceinline__ void row_prescale(f32x4 (&acc)[2][2][4][2], const float* rs, int row0) {
#pragma unroll
    for (int ai = 0; ai < 2; ++ai)
#pragma unroll
        for (int m = 0; m < 4; ++m) { const float s = rs[row0 + ai * HALF + m * 16];
#pragma unroll
            for (int bj = 0; bj < 2; ++bj)
#pragma unroll
                for (int n = 0; n < 2; ++n) acc[ai][bj][m][n] = acc[ai][bj][m][n] * s; }
}
struct EpiPlain {
    static constexpr bool PERM = true, AFTER_DRAIN = false, NEEDS_ALIGN = false;
    bf16_t* O; int ldc;
    __device__ __forceinline__ void operator()(const f32x4 (&acc)[2][2][4][2], const Unit& u, int wr, int wc, int fr, int fq) const {
        const int row0 = u.pm * BM + wr * 64 + fr, col0 = u.pn * BM + wc * 32 + 8 * fq;
#pragma unroll
        for (int ai = 0; ai < 2; ++ai)
#pragma unroll
            for (int m = 0; m < 4; ++m) { bf16_t* rowp = O + (size_t)(row0 + ai * HALF + m * 16) * ldc + col0;
#pragma unroll
                for (int bj = 0; bj < 2; ++bj) { const f32x4 v0 = acc[ai][bj][m][0], v1 = acc[ai][bj][m][1];
                    u32x4 w; w.x = pk_bf16(v0[0], v0[1]); w.y = pk_bf16(v0[2], v0[3]); w.z = pk_bf16(v1[0], v1[1]); w.w = pk_bf16(v1[2], v1[3]);
                    *(u32x4*)(rowp + bj * HALF) = w; } }
    }
};
constexpr int GELU_TAB_N = 3072; constexpr float GELU_TAB_SCALE = 512.0f;
__device__ __forceinline__ void gelu_tab8(f32x4& v0, f32x4& v1, const PG8_LAS unsigned char* tab) {
    float v[8] = {v0[0], v0[1], v0[2], v0[3], v1[0], v1[1], v1[2], v1[3]}, fr[8], hv[8]; f32x2 e[8];
#pragma unroll
    for (int i = 0; i < 8; ++i) { const float av = __builtin_fabsf(v[i]), x = __builtin_fminf(av * GELU_TAB_SCALE, (float)GELU_TAB_N - 0.001f);
        e[i] = *(const PG8_LAS f32x2*)(tab + 8u * (unsigned)x); fr[i] = __builtin_amdgcn_fractf(x); hv[i] = 0.5f * v[i] + 0.5f * av; }
    asm volatile("" ::: "memory");
#pragma unroll
    for (int i = 0; i < 8; ++i) v[i] = hv[i] - (e[i].x + fr[i] * e[i].y);
    v0 = (f32x4){v[0], v[1], v[2], v[3]}; v1 = (f32x4){v[4], v[5], v[6], v[7]};
}
template <bool ST, bool TAB = false> struct EpiGeluSplitT {
    static constexpr bool PERM = true, AFTER_DRAIN = false, NEEDS_ALIGN = false;
    bf16_t* O; int ldc; int split_cols; size_t split_stride; float* part; int M_; const PG8_LAS unsigned char* tab;
    __device__ __forceinline__ void operator()(const f32x4 (&acc)[2][2][4][2], const Unit& u, int wr, int wc, int fr, int fq) const {
        const int row0 = u.pm * BM + wr * 64 + fr; int colt = u.pn * BM; bf16_t* base = O;
        const int t = colt / split_cols; base += (size_t)t * split_stride; colt -= t * split_cols;
        const int col0 = colt + wc * 32 + 8 * fq;
        float* pslot = part + ((size_t)((colt / BM) * 4 + wc) * M_) * 2;
#pragma unroll
        for (int ai = 0; ai < 2; ++ai)
#pragma unroll
            for (int m = 0; m < 4; ++m) { const int row = row0 + ai * HALF + m * 16; bf16_t* rowp = (t == 1) ? base + (size_t)(colt / BM) * M_ * BM + (size_t)row * BM + (wc * 32 + 8 * fq) : base + (size_t)row * ldc + col0;     float a1 = 0.f, a2 = 0.f; f32x2 s2 = {0.f, 0.f}, q2 = {0.f, 0.f};
#pragma unroll
                for (int bj = 0; bj < 2; ++bj) { f32x4 v0 = acc[ai][bj][m][0], v1 = acc[ai][bj][m][1];
                    if (TAB) gelu_tab8(v0, v1, tab);
                    else { f32x2 q[4] = {(f32x2){v0[0], v0[1]}, (f32x2){v0[2], v0[3]}, (f32x2){v1[0], v1[1]}, (f32x2){v1[2], v1[3]}}; gelu_pk4(q);
                      v0 = (f32x4){q[0].x, q[0].y, q[1].x, q[1].y}; v1 = (f32x4){q[2].x, q[2].y, q[3].x, q[3].y}; }
                    if (t == 1) {
                      const f32x2 p0 = {v0[0], v0[1]}, p1 = {v0[2], v0[3]}, p2 = {v1[0], v1[1]}, p3 = {v1[2], v1[3]};
                      s2 += (p0 + p1) + (p2 + p3); q2 = p0 * p0 + q2; q2 = p1 * p1 + q2; q2 = p2 * p2 + q2; q2 = p3 * p3 + q2; }
                    u32x4 w; w.x = pk_bf16(v0[0], v0[1]); w.y = pk_bf16(v0[2], v0[3]); w.z = pk_bf16(v1[0], v1[1]); w.w = pk_bf16(v1[2], v1[3]);
                    if (ST) *(u32x4*)(rowp + bj * HALF) = w; else asm volatile("" :: "v"(w)); }
                if (t == 1) { a1 = sum_fq(s2.x + s2.y); a2 = sum_fq(q2.x + q2.y);
                    if (fq == 0) { if (ST) *(f32x2*)(pslot + (size_t)row * 2) = (f32x2){a1, a2}; else asm volatile("" :: "v"(a1), "v"(a2)); } } }
    }
};
#ifndef KNOB_GELU_TAB
#define KNOB_GELU_TAB false
#endif
typedef EpiGeluSplitT<true, KNOB_GELU_TAB> EpiGeluSplit;
struct EpiRetIn {
    static constexpr bool PERM = true, AFTER_DRAIN = false, NEEDS_ALIGN = false;
    bf16_t* O; int M_; const int* pos;
    __device__ __forceinline__ void operator()(const f32x4 (&acc)[2][2][4][2], const Unit& u, int wr, int wc, int fr, int fq) const {
        const int row0 = u.pm * BM + wr * 64 + fr, col0 = u.pn * BM + wc * 32 + 8 * fq;
        const bool rope = u.pn < 16; const float ksc = (u.pn >= 8) ? 0.0625f : 1.0f;
        float fr_[2][4];
#pragma unroll
        for (int bj = 0; bj < 2; ++bj)
#pragma unroll
            for (int p = 0; p < 4; ++p) { const int i = 64 * bj + 16 * wc + 4 * fq + p; fr_[bj][p] = __builtin_amdgcn_exp2f(-(float)i * (13.287712379549449f / 127.0f)) * 0.15915494309189535f; }
#pragma unroll
        for (int ai = 0; ai < 2; ++ai)
#pragma unroll
            for (int m = 0; m < 4; ++m) { const int row = row0 + ai * HALF + m * 16;
                bf16_t* rowp = (u.pn < 16) ? O + (size_t)u.pn * M_ * BM + (size_t)row * BM + (wc * 32 + 8 * fq)
                                           : O + (size_t)u.pn * M_ * BM + (size_t)(wc >> 1) * M_ * 64 + (size_t)row * 64 + ((wc & 1) * 32 + 8 * fq);  const float pp = rope ? (float)pos[row] : 0.f;
#pragma unroll
                for (int bj = 0; bj < 2; ++bj) { f32x4 v0 = acc[ai][bj][m][0], v1 = acc[ai][bj][m][1];
                    if (rope) {
                        float x[8] = {v0[0], v0[1], v0[2], v0[3], v1[0], v1[1], v1[2], v1[3]};
#pragma unroll
                        for (int p = 0; p < 4; ++p) { float rev = pp * fr_[bj][p]; rev = __builtin_amdgcn_fractf(rev); const float sn = __builtin_amdgcn_sinf(rev), cs = __builtin_amdgcn_cosf(rev);
                            const float a = x[2 * p], b = x[2 * p + 1]; x[2 * p] = (a * cs - b * sn) * ksc; x[2 * p + 1] = (b * cs + a * sn) * ksc; }
                        v0 = (f32x4){x[0], x[1], x[2], x[3]}; v1 = (f32x4){x[4], x[5], x[6], x[7]}; }
                    u32x4 w; w.x = pk_bf16(v0[0], v0[1]); w.y = pk_bf16(v0[2], v0[3]); w.z = pk_bf16(v1[0], v1[1]); w.w = pk_bf16(v1[2], v1[3]);
                    *(u32x4*)(rowp + ((u.pn < 16) ? (size_t)bj * HALF : (size_t)bj * 2 * M_ * 64)) = w; } }
    }
};
template <int CTRL> __device__ __forceinline__ float dppz(float v) { return __builtin_bit_cast(float, __builtin_amdgcn_update_dpp(0, __builtin_bit_cast(int, v), CTRL, 0xF, 0xF, true)); }
struct EpiConvGate {
    static constexpr bool PERM = true, AFTER_DRAIN = false, NEEDS_ALIGN = true;
    bf16_t* H; int ldh; const float* cw; const float* cb; float* halo; PG8_LAS unsigned char* tail; int N_, FF_; PG8_LAS float* wl;
    __device__ __forceinline__ void operator()(const f32x4 (&acc)[2][2][4][2], const Unit& u, int wr, int wc, int fr, int fq) const {
        const int cwl = wc * 32 + 8 * fq;
        PG8_LAS float* T = (PG8_LAS float*)tail;
        const int hc = u.pn * 128 + cwl, row0 = u.pm * BM + wr * 64 + fr;
        { const int r = wr * 4 + wc, c2 = fq * 16 + fr;
          const float* src = (r < 6) ? cw + (size_t)(r % 3) * N_ + (r / 3) * FF_ + u.pn * 128 + 2 * c2 : cb + (r - 6) * FF_ + u.pn * 128 + 2 * c2;
          const float sc = (r < 3 || r == 6) ? -1.4426950408889634f : -0.6931471805599453f;
          const f32x2 v = *(const f32x2*)src; *(PG8_LAS f32x2*)(wl + r * 128 + 2 * c2) = v * sc; }
        if (fr >= 14) {
#pragma unroll
            for (int ai = 0; ai < 2; ++ai)
#pragma unroll
                for (int bj = 0; bj < 2; ++bj)
#pragma unroll
                    for (int n = 0; n < 2; ++n) *(PG8_LAS f32x4*)(T + (((2 * ai + wr) * 2 + (fr - 14)) * 256 + 128 * bj + cwl + 4 * n)) = acc[ai][bj][3][n];
        }
        if (wr == 0 && fr < 2) {
#pragma unroll
            for (int bj = 0; bj < 2; ++bj)
#pragma unroll
                for (int n = 0; n < 2; ++n) *(f32x4*)(halo + ((size_t)(u.pm * 4 + fr)) * N_ + u.pn * 256 + 128 * bj + cwl + 4 * n) = acc[0][bj][0][n];
        }
        if (wr == 1 && fr >= 14) {
#pragma unroll
            for (int bj = 0; bj < 2; ++bj)
#pragma unroll
                for (int n = 0; n < 2; ++n) *(f32x4*)(halo + ((size_t)(u.pm * 4 + fr - 12)) * N_ + u.pn * 256 + 128 * bj + cwl + 4 * n) = acc[1][bj][3][n];
        }
        asm volatile("s_waitcnt lgkmcnt(0)" ::: "memory"); __builtin_amdgcn_s_barrier(); asm volatile("" ::: "memory");
#pragma unroll
        for (int n = 0; n < 2; ++n) {
            f32x4 w[2][3], bb[2];
#pragma unroll
            for (int bj = 0; bj < 2; ++bj) {
#pragma unroll
                for (int t = 0; t < 3; ++t) w[bj][t] = *(const PG8_LAS f32x4*)(wl + (3 * bj + t) * 128 + cwl + 4 * n);
                bb[bj] = *(const PG8_LAS f32x4*)(wl + (6 + bj) * 128 + cwl + 4 * n); }
#pragma unroll
            for (int ai = 0; ai < 2; ++ai) {
                f32x4 o1[2], o2[2];
                if (ai == 0 && wr == 0) { o1[0] = o1[1] = o2[0] = o2[1] = (f32x4){0.f, 0.f, 0.f, 0.f}; }
                else { const int pb = 2 * ai + wr - 1;
#pragma unroll
                    for (int bj = 0; bj < 2; ++bj) { const f32x4 t15 = *(const PG8_LAS f32x4*)(T + ((pb * 2 + 1) * 256 + 128 * bj + cwl + 4 * n)), t14 = *(const PG8_LAS f32x4*)(T + ((pb * 2 + 0) * 256 + 128 * bj + cwl + 4 * n));
                        const f32x4 z4 = (f32x4){0.f, 0.f, 0.f, 0.f}; o1[bj] = (fr == 0) ? t15 : z4; o2[bj] = (fr == 0) ? t14 : ((fr == 1) ? t15 : z4); } }
#pragma unroll
                for (int m = 0; m < 4; ++m) {
                    f32x4 zc[2];
#pragma unroll
                    for (int bj = 0; bj < 2; ++bj) { const f32x4 cur = acc[ai][bj][m][n]; f32x4 r;
#pragma unroll
                        for (int e = 0; e < 4; ++e) {
                            float v = bb[bj][e] + w[bj][2][e] * cur[e];
                            asm("v_fmac_f32_dpp %0, %1, %2 row_shr:1 row_mask:0xf bank_mask:0xf bound_ctrl:1" : "+v"(v) : "v"(cur[e]), "v"(w[bj][1][e]));
                            asm("v_fmac_f32_dpp %0, %1, %2 row_shr:2 row_mask:0xf bank_mask:0xf bound_ctrl:1" : "+v"(v) : "v"(cur[e]), "v"(w[bj][0][e]));
                            if (m == 0) { v += w[bj][1][e] * o1[bj][e]; v += w[bj][0][e] * o2[bj][e]; }
                            else { const float pv = acc[ai][bj][m - 1][n][e];
                                asm("v_fmac_f32_dpp %0, %1, %2 row_shl:15 row_mask:0xf bank_mask:0xf bound_ctrl:1" : "+v"(v) : "v"(pv), "v"(w[bj][1][e]));
                                asm("v_fmac_f32_dpp %0, %1, %2 row_shl:14 row_mask:0xf bank_mask:0xf bound_ctrl:1" : "+v"(v) : "v"(pv), "v"(w[bj][0][e])); }
                            r[e] = v; }
                        zc[bj] = r; }
                    float hv[4];
#pragma unroll
                    for (int e = 0; e < 4; ++e) { const float g = zc[0][e]; hv[e] = g * __builtin_amdgcn_rcpf(1.0f + __builtin_amdgcn_exp2f(g)) * zc[1][e]; }
                    typedef unsigned u32x2 __attribute__((ext_vector_type(2)));
                    *(u32x2*)(H + (size_t)(row0 + ai * HALF + m * 16) * ldh + hc + 4 * n) = (u32x2){pk_bf16(hv[0], hv[1]), pk_bf16(hv[2], hv[3])};
                }
            }
            asm volatile("" ::: "memory"); __builtin_amdgcn_sched_barrier(0);
        }
    }
};
struct EpiConvGate4 {
    static constexpr bool PERM = true, AFTER_DRAIN = false, NEEDS_ALIGN = true, APERM4 = true;
    bf16_t* H; int ldh; const float* cw; const float* cb; float* halo; PG8_LAS unsigned char* tail; int N_, FF_; PG8_LAS float* wl; StaticOrder So; mutable int ui_;
    __device__ __forceinline__ void operator()(const f32x4 (&acc)[2][2][4][2], const Unit& u, int wr, int wc, int fr, int fq) const {
        const int cwl = wc * 32 + 8 * fq;
        PG8_LAS float* T = (PG8_LAS float*)tail;
        const int hc = u.pn * 128 + cwl, rowb = u.pm * BM + wr * 64 + 4 * fr;
        const int wrow = wr * 4 + wc, wc2 = fq * 16 + fr;
        const float wsc = (wrow < 3 || wrow == 6) ? -1.4426950408889634f : -0.6931471805599453f;
        const float* wsrc0 = (wrow < 6) ? cw + (size_t)(wrow % 3) * N_ + (wrow / 3) * FF_ + 2 * wc2 : cb + (wrow - 6) * FF_ + 2 * wc2;
        PG8_LAS float* wlc = wl + (ui_ & 1) * 1024;
        if (ui_ == 0) { const f32x2 v = *(const f32x2*)(wsrc0 + u.pn * 128); *(PG8_LAS f32x2*)(wlc + wrow * 128 + 2 * wc2) = v * wsc; }
        if (fr == 15) {
#pragma unroll
            for (int ai = 0; ai < 2; ++ai)
#pragma unroll
                for (int bj = 0; bj < 2; ++bj)
#pragma unroll
                    for (int n = 0; n < 2; ++n) { *(PG8_LAS f32x4*)(T + (((2 * ai + wr) * 2 + 0) * 256 + 128 * bj + cwl + 4 * n)) = acc[ai][bj][2][n];
                                                  *(PG8_LAS f32x4*)(T + (((2 * ai + wr) * 2 + 1) * 256 + 128 * bj + cwl + 4 * n)) = acc[ai][bj][3][n]; }
        }
        if (wr == 0 && fr == 0) {
#pragma unroll
            for (int bj = 0; bj < 2; ++bj)
#pragma unroll
                for (int n = 0; n < 2; ++n) { *(f32x4*)(halo + ((size_t)(u.pm * 4 + 0)) * N_ + u.pn * 256 + 128 * bj + cwl + 4 * n) = acc[0][bj][0][n];
                                              *(f32x4*)(halo + ((size_t)(u.pm * 4 + 1)) * N_ + u.pn * 256 + 128 * bj + cwl + 4 * n) = acc[0][bj][1][n]; }
        }
        if (wr == 1 && fr == 15) {
#pragma unroll
            for (int bj = 0; bj < 2; ++bj)
#pragma unroll
                for (int n = 0; n < 2; ++n) { *(f32x4*)(halo + ((size_t)(u.pm * 4 + 2)) * N_ + u.pn * 256 + 128 * bj + cwl + 4 * n) = acc[1][bj][2][n];
                                              *(f32x4*)(halo + ((size_t)(u.pm * 4 + 3)) * N_ + u.pn * 256 + 128 * bj + cwl + 4 * n) = acc[1][bj][3][n]; }
        }
        asm volatile("s_waitcnt lgkmcnt(0)" ::: "memory"); __builtin_amdgcn_s_barrier(); asm volatile("" ::: "memory");
        Unit nxu; const bool has_nx = So.next(ui_ + 1, nxu);
        f32x2 wnext = {0.f, 0.f}; if (has_nx) wnext = *(const f32x2*)(wsrc0 + nxu.pn * 128);
#pragma unroll
        for (int n = 0; n < 2; ++n) {
            f32x4 w[2][3], bb[2];
#pragma unroll
            for (int bj = 0; bj < 2; ++bj) {
#pragma unroll
                for (int t = 0; t < 3; ++t) w[bj][t] = *(const PG8_LAS f32x4*)(wlc + (3 * bj + t) * 128 + cwl + 4 * n);
                bb[bj] = *(const PG8_LAS f32x4*)(wlc + (6 + bj) * 128 + cwl + 4 * n); }
#pragma unroll
            for (int ai = 0; ai < 2; ++ai) {
                f32x4 zc[4][2];
#pragma unroll
                for (int bj = 0; bj < 2; ++bj) {
                    f32x4 t15 = (f32x4){0.f, 0.f, 0.f, 0.f}, t14 = (f32x4){0.f, 0.f, 0.f, 0.f};
                    if (!(ai == 0 && wr == 0) && fr == 0) { const int pb = 2 * ai + wr - 1;
                        t15 = *(const PG8_LAS f32x4*)(T + ((pb * 2 + 1) * 256 + 128 * bj + cwl + 4 * n)); t14 = *(const PG8_LAS f32x4*)(T + ((pb * 2 + 0) * 256 + 128 * bj + cwl + 4 * n)); }
                    const f32x4 z0 = acc[ai][bj][0][n], z1 = acc[ai][bj][1][n], z2 = acc[ai][bj][2][n], z3 = acc[ai][bj][3][n];
                    f32x4 v0 = bb[bj] + w[bj][2] * z0 + w[bj][1] * t15 + w[bj][0] * t14;
                    f32x4 v1 = bb[bj] + w[bj][2] * z1 + w[bj][1] * z0 + w[bj][0] * t15;
                    const f32x4 v2 = bb[bj] + w[bj][2] * z2 + w[bj][1] * z1 + w[bj][0] * z0;
                    const f32x4 v3 = bb[bj] + w[bj][2] * z3 + w[bj][1] * z2 + w[bj][0] * z1;
#pragma unroll
                    for (int e = 0; e < 4; ++e) {
                        float x0 = v0[e], x1 = v1[e];
                        asm("v_fmac_f32_dpp %0, %1, %2 row_shr:1 row_mask:0xf bank_mask:0xf bound_ctrl:1" : "+v"(x0) : "v"(z3[e]), "v"(w[bj][1][e]));
                        asm("v_fmac_f32_dpp %0, %1, %2 row_shr:1 row_mask:0xf bank_mask:0xf bound_ctrl:1" : "+v"(x0) : "v"(z2[e]), "v"(w[bj][0][e]));
                        asm("v_fmac_f32_dpp %0, %1, %2 row_shr:1 row_mask:0xf bank_mask:0xf bound_ctrl:1" : "+v"(x1) : "v"(z3[e]), "v"(w[bj][0][e]));
                        v0[e] = x0; v1[e] = x1; }
                    zc[0][bj] = v0; zc[1][bj] = v1; zc[2][bj] = v2; zc[3][bj] = v3; }
#pragma unroll
                for (int m = 0; m < 4; ++m) {
                    float hv[4];
#pragma unroll
                    for (int e = 0; e < 4; ++e) { const float g = zc[m][0][e]; hv[e] = g * __builtin_amdgcn_rcpf(1.0f + __builtin_amdgcn_exp2f(g)) * zc[m][1][e]; }
                    typedef unsigned u32x2 __attribute__((ext_vector_type(2)));
                    *(u32x2*)(H + (size_t)(rowb + ai * HALF + m) * ldh + hc + 4 * n) = (u32x2){pk_bf16(hv[0], hv[1]), pk_bf16(hv[2], hv[3])};
                }
            }
            asm volatile("" ::: "memory"); __builtin_amdgcn_sched_barrier(0);
        }
        if (has_nx) *(PG8_LAS f32x2*)(wl + ((ui_ + 1) & 1) * 1024 + wrow * 128 + 2 * wc2) = wnext * wsc;
        ++ui_;
    }
};
struct EpiPlainKS {
    static constexpr bool PERM = true, AFTER_DRAIN = false, NEEDS_ALIGN = false, KSCALE = true;
    bf16_t* O; int ldc; const PG8_LAS float* tab;
    __device__ __forceinline__ void kscale(f32x4 (&acc)[2][2][4][2], int ui, int kb, int wr, int fr) const {
#pragma unroll
        for (int ai = 0; ai < 2; ++ai)
#pragma unroll
            for (int m = 0; m < 4; ++m) { const float s = tab[((ui & 1) * 256 + ai * HALF + wr * 64 + m * 16 + fr) * 8 + kb];
#pragma unroll
                for (int bj = 0; bj < 2; ++bj)
#pragma unroll
                    for (int n = 0; n < 2; ++n) acc[ai][bj][m][n] = acc[ai][bj][m][n] * s; }
    }
    __device__ __forceinline__ void operator()(const f32x4 (&acc)[2][2][4][2], const Unit& u, int wr, int wc, int fr, int fq) const {
        const int row0 = u.pm * BM + wr * 64 + fr, col0 = u.pn * BM + wc * 32 + 8 * fq;
#pragma unroll
        for (int ai = 0; ai < 2; ++ai)
#pragma unroll
            for (int m = 0; m < 4; ++m) { bf16_t* rowp = O + (size_t)(row0 + ai * HALF + m * 16) * ldc + col0;
#pragma unroll
                for (int bj = 0; bj < 2; ++bj) { const f32x4 v0 = acc[ai][bj][m][0], v1 = acc[ai][bj][m][1];
                    u32x4 w; w.x = pk_bf16(v0[0], v0[1]); w.y = pk_bf16(v0[2], v0[3]); w.z = pk_bf16(v1[0], v1[1]); w.w = pk_bf16(v1[2], v1[3]);
                    *(u32x4*)(rowp + bj * HALF) = w; } }
    }
};
struct EpiNull {
    static constexpr bool PERM = true, AFTER_DRAIN = false, NEEDS_ALIGN = false;
    __device__ __forceinline__ void operator()(const f32x4 (&acc)[2][2][4][2], const Unit& u, int wr, int wc, int fr, int fq) const {
#pragma unroll
        for (int ai = 0; ai < 2; ++ai)
#pragma unroll
            for (int bj = 0; bj < 2; ++bj)
#pragma unroll
                for (int m = 0; m < 4; ++m)
#pragma unroll
                    for (int n = 0; n < 2; ++n) asm volatile("" :: "v"(acc[ai][bj][m][n]));
    }
};
}
constexpr int NWAVES = 8;
constexpr int NB = 4, SEQ = 4096, M = NB * SEQ, D = 2048;
constexpr int GH = 6144, GD = 2 * GH;
constexpr int RPROJ = 12288, RV = 4096;
constexpr int FF = 5632, FF2 = 2 * FF;
constexpr float EPS = 1e-6f;
constexpr size_t MiB = 1u << 20;
constexpr size_t WS_CTL = 0, WS_STATS = 1 * MiB, ZERO_BYTES = 128 * 1024;
constexpr size_t WS_WA = 2 * MiB;
constexpr size_t WS_WB = 50 * MiB;
constexpr size_t WS_HN = 74 * MiB;
constexpr size_t WS_BIG = 138 * MiB;
constexpr size_t WS_H2 = 522 * MiB;
constexpr size_t WS_END = 698 * MiB;
constexpr size_t ST_S1 = 0, ST_S2 = (size_t)M * 4, ST_SS = (size_t)M * 8;
static_assert(ST_SS + (size_t)8 * M * 4 <= MiB, "stats region");
static_assert((size_t)M * RV * 2 + (size_t)128 * M * 4 <= WS_END - WS_H2, "retention output + partial sums of squares fit in H2");
constexpr int CW_TMO = 0, CW_CODE = 1, CW_BAR = 4096, CW_DBG = 16384;
constexpr int RING_BYTES = 131072, LDSCTL_OFF = RING_BYTES, MISC_OFF = LDSCTL_OFF + 320, LDS_BYTES = 163840, TAIL_OFF = 132096, RTAB_OFF = 140288;
static_assert(TAIL_OFF >= MISC_OFF + 128 && TAIL_OFF + 8192 <= RTAB_OFF && RTAB_OFF + 16384 <= LDS_BYTES, "LDS map");
#define GAS __attribute__((address_space(1)))
#define LAS __attribute__((address_space(3)))
typedef unsigned short bf16;
typedef unsigned v4u __attribute__((ext_vector_type(4)));
typedef float f32x4 __attribute__((ext_vector_type(4)));
typedef short bf16x8 __attribute__((ext_vector_type(8)));
typedef GAS unsigned gu32;
typedef GAS unsigned long long gu64;
#define RLX_AGENT __ATOMIC_RELAXED, __HIP_MEMORY_SCOPE_AGENT
#define LDS_WAIT() asm volatile("s_waitcnt lgkmcnt(0)" ::: "memory")
#define VM_WAIT() asm volatile("s_waitcnt vmcnt(0)" ::: "memory")
__device__ __forceinline__ unsigned long long rt() { return __builtin_amdgcn_s_memrealtime(); }
__device__ __forceinline__ unsigned f2bf(float f) { unsigned u = __builtin_bit_cast(unsigned, f); return (u + 0x7fffu + ((u >> 16) & 1u)) >> 16; }
__device__ __forceinline__ unsigned pk2(float lo, float hi) { return f2bf(lo) | (f2bf(hi) << 16); }

#define XB_TMO      128
#define XB_XCNT(j)  (256  + 64 * (j))
#define XB_XSUB(j)  (1280 + 64 * (j))
#define XB_XGEN(j)  (2304 + 64 * (j))
#define XB_TOP      3328
#define XB_TOPGEN   3392
#define XCD_BAR_WORDS 3456
#define XB_SPIN_CAP (1u << 18)

__device__ __forceinline__ unsigned xb_ld(unsigned* p)              { return __hip_atomic_load(p, __ATOMIC_RELAXED, __HIP_MEMORY_SCOPE_AGENT); }
__device__ __forceinline__ unsigned xb_add(unsigned* p, unsigned v) { return __hip_atomic_fetch_add(p, v, __ATOMIC_RELAXED, __HIP_MEMORY_SCOPE_AGENT); }
__device__ __forceinline__ unsigned xb_xcc_id() { return (unsigned)__builtin_amdgcn_s_getreg((3 << 11) | 20) & 0xFu; }
#define XB_SPIN(cond, bar) do { unsigned _sp = 0; while (cond) { __builtin_amdgcn_s_sleep(1); \
    if ((++_sp & 255u) == 0u) { if (xb_ld(&(bar)[XB_TMO])) break; if (_sp > XB_SPIN_CAP) { atomicAdd(&(bar)[XB_TMO], 1u); break; } } } } while (0)

struct XcdBarrier {
    unsigned* bar; unsigned x;
    volatile LAS unsigned* st;
};

__device__ __forceinline__ XcdBarrier xcd_barrier_post(unsigned* bar, volatile LAS unsigned* st) {
    XcdBarrier b; b.bar = bar; b.x = xb_xcc_id(); b.st = st;
    if (threadIdx.x == 0) (void)xb_add(&bar[XB_XCNT(b.x)], 1u);
    return b;
}
__device__ __forceinline__ void xcd_barrier_complete(unsigned* bar, unsigned x, unsigned& nloc, unsigned& nx) {
    const unsigned G = gridDim.x * gridDim.y * gridDim.z;
    unsigned sum, cnt, mine, sp = 0u;
    for (;;) {
        sum = 0u; cnt = 0u; mine = 0u;
#pragma unroll
        for (unsigned j = 0; j < 16; ++j) { const unsigned c = xb_ld(&bar[XB_XCNT(j)]); sum += c; cnt += (c > 0u) ? 1u : 0u; mine = (j == x) ? c : mine; }
        if (sum == G) break;
        __builtin_amdgcn_s_sleep(1);
        if ((++sp & 255u) == 0u) { if (xb_ld(&bar[XB_TMO])) break; if (sp > XB_SPIN_CAP) { atomicAdd(&bar[XB_TMO], 1u); break; } }
    }
    nloc = mine > 0u ? mine : 1u; nx = cnt > 0u ? cnt : 1u;
}

__device__ __forceinline__ void xcd_barrier(const XcdBarrier& b) {
    asm volatile("s_waitcnt vmcnt(0)" ::: "memory");
    __syncthreads();
    if (threadIdx.x == 0) {
        unsigned* bar = b.bar;
        __builtin_amdgcn_s_waitcnt(0);
        unsigned nloc = b.st[0], nx = b.st[1];
        if (nloc == 0u) { xcd_barrier_complete(bar, b.x, nloc, nx); b.st[0] = nloc; b.st[1] = nx; }
        const unsigned old = xb_add(&bar[XB_XSUB(b.x)], 1u);
        const unsigned gen = old / nloc;
        if (old + 1u == (gen + 1u) * nloc) {
            __builtin_amdgcn_fence(__ATOMIC_RELEASE, "agent");
            asm volatile("s_waitcnt vmcnt(0)" ::: "memory");
            const unsigned og = xb_add(&bar[XB_TOP], 1u);
            const unsigned tg = og / nx;
            if (og + 1u == (tg + 1u) * nx) xb_add(&bar[XB_TOPGEN], 1u);
            else XB_SPIN(xb_ld(&bar[XB_TOPGEN]) == tg, bar);
            __builtin_amdgcn_fence(__ATOMIC_ACQUIRE, "agent");
            xb_add(&bar[XB_XGEN(b.x)], 1u);
            asm volatile("s_waitcnt vmcnt(0)" ::: "memory");
        } else {
            XB_SPIN(xb_ld(&bar[XB_XGEN(b.x)]) == gen, bar);
            __builtin_amdgcn_fence(__ATOMIC_ACQUIRE, "agent");
            asm volatile("s_waitcnt vmcnt(0)" ::: "memory");
        }
    }
    __syncthreads();
}
template <int CTRL> __device__ __forceinline__ float dppf(float v) { return __builtin_bit_cast(float, __builtin_amdgcn_mov_dpp(__builtin_bit_cast(int, v), CTRL, 0xF, 0xF, true)); }
__device__ __forceinline__ float wave_sum(float v) {
    v += dppf<0xB1>(v); v += dppf<0x4E>(v); v += dppf<0x141>(v); v += dppf<0x140>(v);
    v += __builtin_bit_cast(float, __builtin_amdgcn_ds_swizzle(__builtin_bit_cast(int, v), 0x401F));
    return __builtin_bit_cast(float, __builtin_amdgcn_readlane(__builtin_bit_cast(int, v), 0)) + __builtin_bit_cast(float, __builtin_amdgcn_readlane(__builtin_bit_cast(int, v), 32));
}
#ifdef CVT_NT_LOADS
#define CVT_LD(p) __builtin_nontemporal_load(p)
#else
#define CVT_LD(p) (*(p))
#endif
template <bool ILV = false, bool GAIN = false, int CVD = 0> __device__ __forceinline__ void cvt_items(const float* W, int K, int N, bf16* WT, LAS float* scr, int it0, int it_end, int stride, int lane, const float* gk = nullptr) {
    const int nblk = N / 32;
    float v[32];
#define CV_LOAD(it_) do { const int kb_ = (it_) / nblk, nb_ = (it_) % nblk; const float* p_ = W + (size_t)(64 * kb_ + (lane >> 5)) * N + 32 * nb_ + (lane & 31); \
        const float* pc_ = W + (size_t)(it_) * 2048 + lane;     \
        _Pragma("unroll") for (int i = 0; i < 32; ++i) { if (CVD == 2) v[i] = (float)(i + (it_)); else if (CVD == 4) v[i] = CVT_LD(pc_ + 64 * i); else v[i] = CVT_LD(p_ + (size_t)(2 * i) * N); } } while (0)
    if (it0 < it_end) CV_LOAD(it0);
    for (int item = it0; item < it_end; item += stride) {
        const int kb = item / nblk, nb = item % nblk, k0 = 64 * kb, n0 = 32 * nb;
        if (CVD != 3) {
#pragma unroll
            for (int i = 0; i < 32; ++i) scr[(2 * i + (lane >> 5)) * 33 + (lane & 31)] = v[i]; }
        float keep[32];
        if (CVD == 3) {
#pragma unroll
            for (int i = 0; i < 32; ++i) keep[i] = v[i]; }
        if (item + stride < it_end) CV_LOAD(item + stride);
        LDS_WAIT(); asm volatile("" ::: "memory");
        const int c = lane & 7;
        float gv[8];
        if (GAIN) { const f32x4 ga = *(const GAS f32x4*)(gk + k0 + 8 * c), gb = *(const GAS f32x4*)(gk + k0 + 8 * c + 4); gv[0] = ga.x; gv[1] = ga.y; gv[2] = ga.z; gv[3] = ga.w; gv[4] = gb.x; gv[5] = gb.y; gv[6] = gb.z; gv[7] = gb.w; }
#pragma unroll
        for (int j = 0; j < 4; ++j) { const int n = (lane >> 3) + 8 * j; const LAS float* s = scr + (8 * c) * 33 + n;
            v4u o;
            if (CVD == 3) { o.x = pk2(keep[8 * j], keep[8 * j + 1]); o.y = pk2(keep[8 * j + 2], keep[8 * j + 3]); o.z = pk2(keep[8 * j + 4], keep[8 * j + 5]); o.w = pk2(keep[8 * j + 6], keep[8 * j + 7]); }
            else if (GAIN) { o.x = pk2(s[0 * 33] * gv[0], s[1 * 33] * gv[1]); o.y = pk2(s[2 * 33] * gv[2], s[3 * 33] * gv[3]); o.z = pk2(s[4 * 33] * gv[4], s[5 * 33] * gv[5]); o.w = pk2(s[6 * 33] * gv[6], s[7 * 33] * gv[7]); }
            else { o.x = pk2(s[0 * 33], s[1 * 33]); o.y = pk2(s[2 * 33], s[3 * 33]); o.z = pk2(s[4 * 33], s[5 * 33]); o.w = pk2(s[6 * 33], s[7 * 33]); }
            const int nr = ILV ? ((n0 < N / 2) ? (n0 >> 7) * 256 + (n0 & 127) : (((n0 - N / 2) >> 7) * 256 + 128 + ((n0 - N / 2) & 127))) : n0;
            if (CVD == 1) asm volatile("" :: "v"(o)); else *(GAS v4u*)(WT + (size_t)(nr + n) * K + k0 + 8 * c) = o; }
        LDS_WAIT(); asm volatile("" ::: "memory");
    }
#undef CV_LOAD
}

template <bool ILV = false, bool GAIN = false> __device__ __forceinline__ void cvt_blocks(const float* W, int K, int N, bf16* WT, LAS unsigned char* lds, int b0, int b_end, int bstride, int tid, const float* gk = nullptr) {
    constexpr int PITCH = 257;
    const int w = tid >> 6, l = tid & 63, nbk = N / 256;
    f32x4 v[8];
#define CB_LOAD(bi_) do { const int kb_ = (bi_) / nbk, nb_ = (bi_) % nbk; const float* p_ = W + (size_t)(64 * kb_ + 8 * w) * N + 256 * nb_ + 4 * l; \
        _Pragma("unroll") for (int r = 0; r < 8; ++r) v[r] = CVT_LD((const GAS f32x4*)(p_ + (size_t)r * N)); } while (0)
    if (b0 < b_end) CB_LOAD(b0);
    int buf = 0;
    for (int bi = b0; bi < b_end; bi += bstride, buf ^= 1) {
        const int kb = bi / nbk, nb = bi % nbk, k0 = 64 * kb, n0 = 256 * nb;
        LAS unsigned* T = (LAS unsigned*)(lds + buf * 36864);
        if (GAIN) {
#pragma unroll
            for (int r = 0; r < 8; ++r) v[r] = v[r] * gk[k0 + 8 * w + r]; }
#pragma unroll
        for (int p = 0; p < 4; ++p) { v4u d; d.x = pk2(v[2 * p].x, v[2 * p + 1].x); d.y = pk2(v[2 * p].y, v[2 * p + 1].y); d.z = pk2(v[2 * p].z, v[2 * p + 1].z); d.w = pk2(v[2 * p].w, v[2 * p + 1].w);
            LAS unsigned* q = T + (4 * w + p) * PITCH + 4 * l; q[0] = d.x; q[1] = d.y; q[2] = d.z; q[3] = d.w; }
        if (bi + bstride < b_end) CB_LOAD(bi + bstride);
        LDS_WAIT(); __builtin_amdgcn_s_barrier(); asm volatile("" ::: "memory");
        const int c = l & 7;
#pragma unroll
        for (int j = 0; j < 4; ++j) { const int n = 32 * w + (l >> 3) + 8 * j; const LAS unsigned* q = T + (4 * c) * PITCH + n;
            v4u o; o.x = q[0]; o.y = q[PITCH]; o.z = q[2 * PITCH]; o.w = q[3 * PITCH];
            const int col = n0 + n;
            const int nr = ILV ? ((col < N / 2) ? (col >> 7) * 256 + (col & 127) : (((col - N / 2) >> 7) * 256 + 128 + ((col - N / 2) & 127))) : col;
            *(GAS v4u*)(WT + (size_t)nr * K + k0 + 8 * c) = o; }
    }
    LDS_WAIT(); __builtin_amdgcn_s_barrier(); asm volatile("" ::: "memory");
#undef CB_LOAD
}
typedef float f32x16 __attribute__((ext_vector_type(16)));
typedef short s16x4 __attribute__((ext_vector_type(4)));
typedef unsigned v2u __attribute__((ext_vector_type(2)));
typedef float f32x2_t __attribute__((ext_vector_type(2))); typedef __bf16 bf16x2_t __attribute__((ext_vector_type(2)));
__device__ __forceinline__ unsigned pkbf(float lo, float hi) { f32x2_t v = {lo, hi}; bf16x2_t b = __builtin_convertvector(v, bf16x2_t); return __builtin_bit_cast(unsigned, b); }
__device__ __forceinline__ float bflo(unsigned w) { return __builtin_bit_cast(float, w << 16); }
__device__ __forceinline__ float bfhi(unsigned w) { return __builtin_bit_cast(float, w & 0xffff0000u); }
__device__ __forceinline__ void unpack8(const v4u& w, float (&f)[8]) { f[0] = bflo(w.x); f[1] = bfhi(w.x); f[2] = bflo(w.y); f[3] = bfhi(w.y); f[4] = bflo(w.z); f[5] = bfhi(w.z); f[6] = bflo(w.w); f[7] = bfhi(w.w); }
__device__ __forceinline__ v4u pack8(const float (&f)[8]) { v4u w; w.x = pkbf(f[0], f[1]); w.y = pkbf(f[2], f[3]); w.z = pkbf(f[4], f[5]); w.w = pkbf(f[6], f[7]); return w; }
__device__ __forceinline__ s16x4 tr_rd(LAS const unsigned char* p) { typedef short v4i16_t __attribute__((ext_vector_type(4))); return __builtin_bit_cast(s16x4, __builtin_amdgcn_ds_read_tr16_b64_v4i16((LAS v4i16_t*)p)); }
__device__ __forceinline__ bf16x8 cat8(s16x4 lo, s16x4 hi) { return __builtin_shufflevector(lo, hi, 0, 1, 2, 3, 4, 5, 6, 7); }
#define MFMA32(a, b, c) __builtin_amdgcn_mfma_f32_32x32x16_bf16((a), (b), (c), 0, 0, 0)
__device__ __forceinline__ f32x16 zero16() { f32x16 z;
#pragma unroll
    for (int i = 0; i < 16; ++i) z[i] = 0.f; return z; }
__device__ __forceinline__ float silu_f(float x) { return x * __builtin_amdgcn_rcpf(1.0f + __builtin_amdgcn_exp2f(-1.4426950408889634f * x)); }

__device__ __forceinline__ size_t blk_off(int row, int col, int KT) { return ((size_t)(row >> 8) * KT + (col >> 6)) * 16384 + ((row & 255) << 6) + (col & 63); }
template <bool ILV = false, int CVD = 0> __device__ __forceinline__ void convert_weight(const float* W, int K, int N, bf16* WT, LAS unsigned char* lds, int gw, int NGW, int wave, int lane) {
    LAS float* scr = (LAS float*)(lds + wave * 16384);
    const int nblk = N / 32, nitems = (K / 64) * nblk;
    cvt_items<ILV, false, CVD>(W, K, N, WT, scr, gw, nitems, NGW, lane);
}

template <bool ILV = false, bool GAIN = false> __device__ __forceinline__ void convert_weight_grp(const float* W, int K, int N, bf16* WT, LAS unsigned char* lds, int grp, int gwl, int NGWL, int wave, int lane, const float* gk = nullptr) {
    LAS float* scr = (LAS float*)(lds + wave * 16384);
    const int nblk = N / 32, nitems = (K / 64) * nblk, h0 = nitems / 2, lo = grp ? h0 : 0, hi = grp ? nitems : h0;
    cvt_items<ILV, GAIN>(W, K, N, WT, scr, lo + gwl, hi, NGWL, lane, gk);
}
template <bool ILV = false, bool GAIN = false> __device__ __forceinline__ void convert_weight_stag(const float* W, int K, int N, bf16* WT, LAS unsigned char* lds, int bx, int G, int wave, int lane, int part, const float* gk = nullptr) {
    LAS float* scr = (LAS float*)(lds + wave * 16384);
    const int grp = bx & 3, gwl = (bx >> 2) * NWAVES + wave, NGWL = ((G + 3 - grp) >> 2) * NWAVES;
    const int nblk = N / 32, nitems = (K / 64) * nblk, q = nitems / 4, lo = grp * q, hi = (grp == 3) ? nitems : lo + q;
    const int first = lo + gwl, nj = (first < hi) ? (hi - first + NGWL - 1) / NGWL : 0, npre = (nj * grp + 1) / 3;
    const int j0 = part ? npre : 0, j1 = part ? nj : npre;
    if (j1 > j0) { const int e_ = first + j1 * NGWL; cvt_items<ILV, GAIN>(W, K, N, WT, scr, first + j0 * NGWL, e_ < hi ? e_ : hi, NGWL, lane, gk); }
}
template <bool ILV = false, bool GAIN = false> __device__ __forceinline__ void convert_weight_stagb(const float* W, int K, int N, bf16* WT, LAS unsigned char* lds, int bx, int G, int tid, int part, const float* gk = nullptr) {
    const int grp = bx & 3, wgi = bx >> 2, NW = (G + 3 - grp) >> 2;
    const int nb = (K / 64) * (N / 256), q = nb / 4, lo = grp * q, hi = (grp == 3) ? nb : lo + q;
    const int first = lo + wgi, nj = (first < hi) ? (hi - first + NW - 1) / NW : 0, npre = (nj * grp + 1) / 3;
    const int j0 = part ? npre : 0, j1 = part ? nj : npre;
    if (j1 > j0) { const int e_ = first + j1 * NW; cvt_blocks<ILV, GAIN>(W, K, N, WT, lds, first + j0 * NW, e_ < hi ? e_ : hi, NW, tid, gk); }
}
#ifdef X_NT_LOADS
#define X_LD(p) __builtin_nontemporal_load(p)
#else
#define X_LD(p) (*(p))
#endif
__device__ __forceinline__ void first_norm_phase(int gw, int NGW, int lane, const float* x, const float* g, bf16* hn) {
    float gg[4][8];
#pragma unroll
    for (int j = 0; j < 4; ++j) { const f32x4 a = ((const GAS f32x4*)g)[2 * (lane + 64 * j)], b = ((const GAS f32x4*)g)[2 * (lane + 64 * j) + 1]; gg[j][0] = a.x; gg[j][1] = a.y; gg[j][2] = a.z; gg[j][3] = a.w; gg[j][4] = b.x; gg[j][5] = b.y; gg[j][6] = b.z; gg[j][7] = b.w; }
    for (int m = gw; m < M; m += NGW) {
        const GAS f32x4* xr = (const GAS f32x4*)(x + (size_t)m * D);
        float xv[4][8]; float ss = 0.f;
#pragma unroll
        for (int j = 0; j < 4; ++j) { const f32x4 a = X_LD(xr + 2 * (lane + 64 * j)), b = X_LD(xr + 2 * (lane + 64 * j) + 1); xv[j][0] = a.x; xv[j][1] = a.y; xv[j][2] = a.z; xv[j][3] = a.w; xv[j][4] = b.x; xv[j][5] = b.y; xv[j][6] = b.z; xv[j][7] = b.w;
#pragma unroll
            for (int i = 0; i < 8; ++i) ss += xv[j][i] * xv[j][i]; }
        const float r = rsqrtf(wave_sum(ss) * (1.0f / D) + EPS);
#pragma unroll
        for (int j = 0; j < 4; ++j) { float t[8];
#pragma unroll
            for (int i = 0; i < 8; ++i) t[i] = xv[j][i] * r * gg[j][i];
            *(GAS v4u*)(hn + (size_t)m * D + 8 * (lane + 64 * j)) = pack8(t); }
    }
}
template <bool NEXT>
__device__ __forceinline__ void resid_norm_phase(int gw, int NGW, int lane, const bf16* Y, const float* xin, float* xout, const float* gpost, const float* gnext, bf16* hn) {
    float gp[4][8], gn[4][8];
#pragma unroll
    for (int j = 0; j < 4; ++j) { const f32x4 a = ((const GAS f32x4*)gpost)[2 * (lane + 64 * j)], b = ((const GAS f32x4*)gpost)[2 * (lane + 64 * j) + 1]; gp[j][0] = a.x; gp[j][1] = a.y; gp[j][2] = a.z; gp[j][3] = a.w; gp[j][4] = b.x; gp[j][5] = b.y; gp[j][6] = b.z; gp[j][7] = b.w;
        if (NEXT) { const f32x4 c = ((const GAS f32x4*)gnext)[2 * (lane + 64 * j)], d = ((const GAS f32x4*)gnext)[2 * (lane + 64 * j) + 1]; gn[j][0] = c.x; gn[j][1] = c.y; gn[j][2] = c.z; gn[j][3] = c.w; gn[j][4] = d.x; gn[j][5] = d.y; gn[j][6] = d.z; gn[j][7] = d.w; } }
    for (int m = gw; m < M; m += NGW) {
        const GAS v4u* yr = (const GAS v4u*)(Y + (size_t)m * D);
        const GAS f32x4* xr = (const GAS f32x4*)(xin + (size_t)m * D);
        GAS f32x4* xo = (GAS f32x4*)(xout + (size_t)m * D);
        float yv[4][8], xv[4][8]; float ss = 0.f;
#pragma unroll
        for (int j = 0; j < 4; ++j) { const v4u w = yr[lane + 64 * j]; unpack8(w, yv[j]);
            const f32x4 a = xr[2 * (lane + 64 * j)], b = xr[2 * (lane + 64 * j) + 1]; xv[j][0] = a.x; xv[j][1] = a.y; xv[j][2] = a.z; xv[j][3] = a.w; xv[j][4] = b.x; xv[j][5] = b.y; xv[j][6] = b.z; xv[j][7] = b.w;
#pragma unroll
            for (int i = 0; i < 8; ++i) ss += yv[j][i] * yv[j][i]; }
        const float r1 = rsqrtf(wave_sum(ss) * (1.0f / D) + EPS); float s2 = 0.f;
#pragma unroll
        for (int j = 0; j < 4; ++j) {
#pragma unroll
            for (int i = 0; i < 8; ++i) { xv[j][i] += yv[j][i] * r1 * gp[j][i]; s2 += xv[j][i] * xv[j][i]; }
            xo[2 * (lane + 64 * j)] = (f32x4){xv[j][0], xv[j][1], xv[j][2], xv[j][3]}; xo[2 * (lane + 64 * j) + 1] = (f32x4){xv[j][4], xv[j][5], xv[j][6], xv[j][7]}; }
        if (NEXT) { const float r2 = rsqrtf(wave_sum(s2) * (1.0f / D) + EPS);
#pragma unroll
            for (int j = 0; j < 4; ++j) { float t[8];
#pragma unroll
                for (int i = 0; i < 8; ++i) t[i] = xv[j][i] * r2 * gn[j][i];
                *(GAS v4u*)(hn + (size_t)m * D + 8 * (lane + 64 * j)) = pack8(t); } }
    }
}
template <bool XF32, bool LAST, bool PF = true>
__device__ __forceinline__ void resid_fold_phase(int gw, int NGW, int lane, const bf16* Y, const void* xin, const float* rin, void* xout, float* rout, const float* gpost) {
    float gp[4][8];
#pragma unroll
    for (int j = 0; j < 4; ++j) { const f32x4 a = ((const GAS f32x4*)gpost)[2 * (lane + 64 * j)], b = ((const GAS f32x4*)gpost)[2 * (lane + 64 * j) + 1]; gp[j][0] = a.x; gp[j][1] = a.y; gp[j][2] = a.z; gp[j][3] = a.w; gp[j][4] = b.x; gp[j][5] = b.y; gp[j][6] = b.z; gp[j][7] = b.w; }
    v4u yw[4], xw[XF32 ? 8 : 4]; float riw = 1.0f;
    int lz = 0; asm volatile("" : "+v"(lz));
#define RF_LOAD(m_) do { const GAS v4u* yr_ = (const GAS v4u*)(Y + (size_t)(m_) * D); \
        _Pragma("unroll") for (int j = 0; j < 4; ++j) yw[j] = yr_[lane + 64 * j]; \
        if (XF32) { const GAS v4u* xr_ = (const GAS v4u*)((const float*)xin + (size_t)(m_) * D); _Pragma("unroll") for (int j = 0; j < 4; ++j) { xw[2 * j] = X_LD(xr_ + 2 * (lane + 64 * j)); xw[2 * j + 1] = X_LD(xr_ + 2 * (lane + 64 * j) + 1); } } \
        else { const GAS v4u* xr_ = (const GAS v4u*)((const bf16*)xin + (size_t)(m_) * D); _Pragma("unroll") for (int j = 0; j < 4; ++j) xw[j] = xr_[lane + 64 * j]; riw = ((const GAS float*)rin)[(m_) + lz]; } } while (0)
    if (PF && gw < M) RF_LOAD(gw);
    for (int m = gw; m < M; m += NGW) {
        float yv[4][8], xv[4][8]; float ss = 0.f;
        if (!PF) RF_LOAD(m);
        const float ri = riw;
#pragma unroll
        for (int j = 0; j < 4; ++j) { unpack8(yw[j], yv[j]);
            if (XF32) { const f32x4 a = __builtin_bit_cast(f32x4, xw[2 * j]), b = __builtin_bit_cast(f32x4, xw[2 * j + 1]);
                xv[j][0] = a.x; xv[j][1] = a.y; xv[j][2] = a.z; xv[j][3] = a.w; xv[j][4] = b.x; xv[j][5] = b.y; xv[j][6] = b.z; xv[j][7] = b.w; }
            else unpack8(xw[XF32 ? 2 * j : j], xv[j]);
#pragma unroll
            for (int i = 0; i < 8; ++i) ss += yv[j][i] * yv[j][i]; }
        if (PF && m + NGW < M) RF_LOAD(m + NGW);
        const float r1 = rsqrtf(wave_sum(ss) * (1.0f / D) + EPS); float s2 = 0.f;
#pragma unroll
        for (int j = 0; j < 4; ++j) {
#pragma unroll
            for (int i = 0; i < 8; ++i) { xv[j][i] = (XF32 ? xv[j][i] : xv[j][i] * ri) + yv[j][i] * r1 * gp[j][i]; s2 += xv[j][i] * xv[j][i]; }
            if (LAST) { GAS f32x4* xo = (GAS f32x4*)((float*)xout + (size_t)m * D); xo[2 * (lane + 64 * j)] = (f32x4){xv[j][0], xv[j][1], xv[j][2], xv[j][3]}; xo[2 * (lane + 64 * j) + 1] = (f32x4){xv[j][4], xv[j][5], xv[j][6], xv[j][7]}; } }
        if (!LAST) { const float ms = wave_sum(s2) * (1.0f / D) + EPS, r2 = rsqrtf(ms);
#pragma unroll
            for (int j = 0; j < 4; ++j) { float t[8];
#pragma unroll
                for (int i = 0; i < 8; ++i) t[i] = xv[j][i] * r2;
                *(GAS v4u*)((bf16*)xout + (size_t)m * D + 8 * (lane + 64 * j)) = pack8(t); }
            if (lane == 0) rout[m] = __builtin_sqrtf(ms); }
    }
#undef RF_LOAD
}
__device__ __forceinline__ void conv_gate_phase(int gw, int NGW, int lane, const bf16* Z, bf16* H, const float* cw, const float* cb) {
    constexpr int RB = 32, NRB = M / RB, NCG = FF / 512;
    for (int it = gw; it < NRB * NCG; it += NGW) {
        const int rb = it / NCG, cg = it % NCG, c0 = 8 * (cg * 64 + lane), m0 = rb * RB;
        float wg[3][8], wu[3][8], bg[8], bu[8];
#pragma unroll
        for (int t = 0; t < 3; ++t) { const GAS f32x4* p = (const GAS f32x4*)(cw + (size_t)t * FF2 + c0); const GAS f32x4* q = (const GAS f32x4*)(cw + (size_t)t * FF2 + FF + c0);
            const f32x4 a = p[0], b = p[1], c = q[0], d = q[1]; wg[t][0] = a.x; wg[t][1] = a.y; wg[t][2] = a.z; wg[t][3] = a.w; wg[t][4] = b.x; wg[t][5] = b.y; wg[t][6] = b.z; wg[t][7] = b.w;
            wu[t][0] = c.x; wu[t][1] = c.y; wu[t][2] = c.z; wu[t][3] = c.w; wu[t][4] = d.x; wu[t][5] = d.y; wu[t][6] = d.z; wu[t][7] = d.w; }
        { const GAS f32x4* p = (const GAS f32x4*)(cb + c0); const GAS f32x4* q = (const GAS f32x4*)(cb + FF + c0); const f32x4 a = p[0], b = p[1], c = q[0], d = q[1];
          bg[0] = a.x; bg[1] = a.y; bg[2] = a.z; bg[3] = a.w; bg[4] = b.x; bg[5] = b.y; bg[6] = b.z; bg[7] = b.w; bu[0] = c.x; bu[1] = c.y; bu[2] = c.z; bu[3] = c.w; bu[4] = d.x; bu[5] = d.y; bu[6] = d.z; bu[7] = d.w; }
        float g1[8], g2[8], u1[8], u2[8];
        if ((m0 % SEQ) == 0) {
#pragma unroll
            for (int i = 0; i < 8; ++i) { g1[i] = 0.f; g2[i] = 0.f; u1[i] = 0.f; u2[i] = 0.f; }
        } else {
            const v4u a = *(const GAS v4u*)(Z + (size_t)(m0 - 1) * FF2 + c0), b = *(const GAS v4u*)(Z + (size_t)(m0 - 2) * FF2 + c0);
            const v4u c = *(const GAS v4u*)(Z + (size_t)(m0 - 1) * FF2 + FF + c0), d = *(const GAS v4u*)(Z + (size_t)(m0 - 2) * FF2 + FF + c0);
            unpack8(a, g1); unpack8(b, g2); unpack8(c, u1); unpack8(d, u2);
        }
#pragma unroll 4
        for (int r = 0; r < RB; ++r) { const int m = m0 + r;
            const v4u a = *(const GAS v4u*)(Z + (size_t)m * FF2 + c0), c = *(const GAS v4u*)(Z + (size_t)m * FF2 + FF + c0);
            float zg[8], zu[8], o[8]; unpack8(a, zg); unpack8(c, zu);
#pragma unroll
            for (int i = 0; i < 8; ++i) { const float gt = bg[i] + wg[0][i] * g2[i] + wg[1][i] * g1[i] + wg[2][i] * zg[i]; const float up = bu[i] + wu[0][i] * u2[i] + wu[1][i] * u1[i] + wu[2][i] * zu[i];
                o[i] = silu_f(gt) * up; g2[i] = g1[i]; g1[i] = zg[i]; u2[i] = u1[i]; u1[i] = zu[i]; }
            *(GAS v4u*)(H + (size_t)m * FF + c0) = pack8(o); }
    }
}
__device__ __forceinline__ void ret_norm_phase(int gw, int NGW, int lane, bf16* O, const float* ssp) {
    for (int m = gw; m < M; m += NGW) {
        v4u ow[8];
#pragma unroll
        for (int j = 0; j < 8; ++j) ow[j] = *(const GAS v4u*)(O + (size_t)m * RV + 8 * (lane + 64 * j));
        float v = ssp[(size_t)lane * M + m] + ssp[(size_t)(lane + 64) * M + m];
        v += dppf<0x128>(v);
        v += __builtin_bit_cast(float, __builtin_amdgcn_ds_swizzle(__builtin_bit_cast(int, v), 0x401F));
        v += __builtin_bit_cast(float, __builtin_amdgcn_ds_bpermute((int)(((unsigned)lane ^ 32u) << 2), __builtin_bit_cast(int, v)));
        const float rl = rsqrtf(v * (1.0f / 512.0f) + EPS);
#pragma unroll
        for (int j = 0; j < 8; ++j) { const float r = __builtin_bit_cast(float, __builtin_amdgcn_readlane(__builtin_bit_cast(int, rl), j));
            float ov[8]; unpack8(ow[j], ov);
#pragma unroll
            for (int i = 0; i < 8; ++i) ov[i] *= r;
            *(GAS v4u*)(O + (size_t)m * RV + 8 * (lane + 64 * j)) = pack8(ov); }
    }
}
__device__ __forceinline__ void ln_stats_phase(int gw, int NGW, int lane, const bf16* V, float* mu, float* rstd) {
    for (int m = gw; m < M; m += NGW) {
        const GAS v4u* vr = (const GAS v4u*)(V + (size_t)m * GH); float a1 = 0.f, a2 = 0.f;
#pragma unroll
        for (int j = 0; j < 12; ++j) { float f[8]; const v4u w = vr[lane + 64 * j]; unpack8(w, f);
#pragma unroll
            for (int i = 0; i < 8; ++i) { a1 += f[i]; a2 += f[i] * f[i]; } }
        const float mean = wave_sum(a1) * (1.0f / GH), var = wave_sum(a2) * (1.0f / GH) - mean * mean;
        if (lane == 0) { mu[m] = mean; rstd[m] = rsqrtf(fmaxf(var, 0.f) + EPS); }
    }
}
__device__ __forceinline__ void ffn_fixup_phase(int gtid, int NT, const float* halo, bf16* H, const float* cw, const float* cb) {
    constexpr int NCH = FF / 8, NIT = (M / 256) * 2 * NCH;
    for (int it = gtid; it < NIT; it += NT) {
        const int ch = it % NCH, r = (it / NCH) & 1, pm = it / (2 * NCH);
        if ((pm & 15) == 0) continue;
        const int hc = 8 * ch, pn = hc >> 7, c = hc & 127;
        float o[8];
#pragma unroll
        for (int half = 0; half < 2; ++half) {
            f32x4 zc[2];
#pragma unroll
            for (int bj = 0; bj < 2; ++bj) {
                const size_t col2 = (size_t)pn * 256 + 128 * bj + c + 4 * half;
                const f32x4 z0 = *(const GAS f32x4*)(halo + ((size_t)(pm * 4 + r)) * FF2 + col2);
                const f32x4 z1 = (r == 1) ? *(const GAS f32x4*)(halo + ((size_t)(pm * 4 + 0)) * FF2 + col2) : *(const GAS f32x4*)(halo + ((size_t)((pm - 1) * 4 + 3)) * FF2 + col2);
                const f32x4 z2 = (r == 1) ? *(const GAS f32x4*)(halo + ((size_t)((pm - 1) * 4 + 3)) * FF2 + col2) : *(const GAS f32x4*)(halo + ((size_t)((pm - 1) * 4 + 2)) * FF2 + col2);
                const size_t oc = (size_t)bj * FF + hc + 4 * half;
                const f32x4 w0 = *(const GAS f32x4*)(cw + oc), w1 = *(const GAS f32x4*)(cw + FF2 + oc), w2 = *(const GAS f32x4*)(cw + 2 * (size_t)FF2 + oc), b = *(const GAS f32x4*)(cb + oc);
                zc[bj] = b + w0 * z2 + w1 * z1 + w2 * z0; }
#pragma unroll
            for (int e = 0; e < 4; ++e) o[4 * half + e] = silu_f(zc[0][e]) * zc[1][e];
        }
        *(GAS v4u*)(H + (size_t)(pm * 256 + r) * FF + hc) = pack8(o);
    }
}
__device__ __forceinline__ void ffn_fixup_local(int tid, int pmA, int pmB, const float* halo, bf16* H, const float* cw, const float* cb) {
    constexpr int NCH = FF / 8;
    const int npan = (pmB >= 0 && pmB != pmA) ? 2 : 1;
    for (int it = tid; it < npan * 2 * NCH; it += NWAVES * 64) {
        const int ch = it % NCH, r = (it / NCH) & 1, pm = (it >= 2 * NCH) ? pmB : pmA;
        if ((pm & 15) == 0) continue;
        const int hc = 8 * ch, pn = hc >> 7, c = hc & 127;
        float o[8];
#pragma unroll
        for (int half = 0; half < 2; ++half) {
            f32x4 zc[2];
#pragma unroll
            for (int bj = 0; bj < 2; ++bj) {
                const size_t col2 = (size_t)pn * 256 + 128 * bj + c + 4 * half;
                const f32x4 z0 = *(const GAS f32x4*)(halo + ((size_t)(pm * 4 + r)) * FF2 + col2);
                const f32x4 z1 = (r == 1) ? *(const GAS f32x4*)(halo + ((size_t)(pm * 4 + 0)) * FF2 + col2) : *(const GAS f32x4*)(halo + ((size_t)((pm - 1) * 4 + 3)) * FF2 + col2);
                const f32x4 z2 = (r == 1) ? *(const GAS f32x4*)(halo + ((size_t)((pm - 1) * 4 + 3)) * FF2 + col2) : *(const GAS f32x4*)(halo + ((size_t)((pm - 1) * 4 + 2)) * FF2 + col2);
                const size_t oc = (size_t)bj * FF + hc + 4 * half;
                const f32x4 w0 = *(const GAS f32x4*)(cw + oc), w1 = *(const GAS f32x4*)(cw + FF2 + oc), w2 = *(const GAS f32x4*)(cw + 2 * (size_t)FF2 + oc), b = *(const GAS f32x4*)(cb + oc);
                zc[bj] = b + w0 * z2 + w1 * z1 + w2 * z0; }
#pragma unroll
            for (int e = 0; e < 4; ++e) o[4 * half + e] = silu_f(zc[0][e]) * zc[1][e];
        }
        *(GAS v4u*)(H + (size_t)(pm * 256 + r) * FF + hc) = pack8(o);
    }
    asm volatile("s_waitcnt vmcnt(0)" ::: "memory");
    __syncthreads();
}
__device__ __forceinline__ void ret_scale_table(LAS float* tab, int tid, int pmA, int pmB, const float* ssp) {
    const int slot = tid >> 8, row = tid & 255, pm = slot ? pmB : pmA;
    if (pm >= 0) {
        float r[8];
#pragma unroll
        for (int h = 0; h < 8; ++h) { float a = 0.f;
#pragma unroll
            for (int sl = 0; sl < 16; ++sl) a += ssp[((size_t)(sl * 8 + h)) * M + pm * 256 + row];
            r[h] = rsqrtf(a * (1.0f / 512.0f) + EPS); }
#pragma unroll
        for (int h = 0; h < 8; ++h) tab[(slot * 256 + row) * 8 + h] = (h < 7) ? r[h] / r[h + 1] : r[7];
    }
    __syncthreads();
}
#define LDS_BARRIER() do { asm volatile("s_waitcnt lgkmcnt(0)" ::: "memory"); __builtin_amdgcn_s_barrier(); asm volatile("" ::: "memory"); } while (0)
#ifndef GATE_DB
#define GATE_DB 0
#endif
struct IC0 { static constexpr int value = 0; }; struct IC1 { static constexpr int value = 1; };
template <bool DUMMY_OUT = false> __device__ __forceinline__ void gating_phase(LAS unsigned char* lds, int vcu, int G, int tid, bf16* U, const bf16* V, const float* part, bf16* dummy,
                                             const float* lng, const float* lnb, const float* ws, const float* bs) {
    constexpr int WSP = 272, VTP = 576, MXP = 528, OFF_WS = 0, OFF_VT = 128 * WSP, OFF_ST = OFF_VT + 128 * VTP, OFF_SQ = OFF_ST + 1024, NUNITS = 8 * 128 * 3;
    static_assert(OFF_SQ + 4 * 128 * 8 <= RING_BYTES && MXP <= VTP, "gating LDS map");
    const int lane = tid & 63, wid = __builtin_amdgcn_readfirstlane(tid >> 6), th = wid >> 2, dq = wid & 3;
    const int l31 = lane & 31, h = lane >> 5, blk = (lane >> 4) & 1, q = (lane & 15) >> 2, p = lane & 3;
    const int dchunk = tid & 31, rg = tid >> 5;
    const int vpos = 32 * (dchunk >> 2) + 16 * (dchunk & 1) + 4 * ((dchunk & 3) >> 1);
    LAS const unsigned char* vt_rd = lds + OFF_VT + (8 * h + q) * VTP + (64 * dq + 16 * blk + 4 * p) * 2;
    LAS const unsigned char* ws_rd = lds + OFF_WS + (64 * th + l31) * WSP + 16 * h;
    LAS float* stl = (LAS float*)(lds + OFF_ST);
    LAS float* sql = (LAS float*)(lds + OFF_SQ);
    const int g = vcu & 7, wk = vcu >> 3, upw = NUNITS / G;
    for (int i = tid; i < 128 * 16; i += NWAVES * 64) { const int t = i >> 4, c8 = (i & 15) * 8; const GAS f32x4* wp = (const GAS f32x4*)(ws + ((size_t)g * 128 + t) * 128 + c8);
        const f32x4 a = wp[0], b = wp[1]; float f[8] = {a.x, a.y, a.z, a.w, b.x, b.y, b.z, b.w};
#pragma unroll
        for (int k = 0; k < 8; ++k) f[k] = (c8 + k <= t) ? f[k] : 0.f;
        *(LAS v4u*)(lds + OFF_WS + t * WSP + c8 * 2) = pack8(f); }
    const float bsv[2] = {bs[g * 128 + 64 * th + l31], bs[g * 128 + 64 * th + 32 + l31]};
    v4u vreg[1][8], ureg[GATE_DB ? 2 : 1][8];
    f32x2_t pn[8]; float sn1 = 0.f, sn2 = 0.f; bool pn_live = false;
    int ci_cur = -1;
#define GT_DECODE(k_, ci_, cb_) const int rest_ = wk * upw + (k_), ci_ = rest_ / 3, cb_ = rest_ % 3
#define GT_LOADV(dst, base, ci_, cb_) do { const bf16* vp_ = (base) + (size_t)(3 * g + (cb_)) * M * 256 + (size_t)((ci_) * 128 + rg) * 256 + 8 * dchunk; \
        _Pragma("unroll") for (int ps = 0; ps < 8; ++ps) dst[ps] = *(const GAS v4u*)(vp_ + (size_t)(16 * ps) * 256); } while (0)
#define GT_LOAD(dst, base, ci_, cb_) do { const bf16* vp_ = (base) + (size_t)((ci_) * 128 + rg) * GH + g * 768 + (cb_) * 256 + 8 * dchunk; \
        _Pragma("unroll") for (int ps = 0; ps < 8; ++ps) dst[ps] = *(const GAS v4u*)(vp_ + (size_t)(16 * ps) * GH); } while (0)
#define GT_LNW(cb_) do { const GAS f32x4* gp_ = (const GAS f32x4*)(lng + g * 768 + (cb_) * 256 + 8 * dchunk); const GAS f32x4* bp_ = (const GAS f32x4*)(lnb + g * 768 + (cb_) * 256 + 8 * dchunk); \
        lnw[0] = gp_[0]; lnw[1] = gp_[1]; lnw[2] = bp_[0]; lnw[3] = bp_[1]; } while (0)
    f32x4 lnw[4];
    { GT_DECODE(0, ci0, cb0); GT_LOADV(vreg[0], V, ci0, cb0); GT_LOAD(ureg[0], U, ci0, cb0); GT_LNW(cb0); }
    auto unit_body = [&](const int k, auto PC) { constexpr int P = GATE_DB ? decltype(PC)::value : 0, Q = GATE_DB ? 1 - P : 0;
        GT_DECODE(k, ci, cb); const int m0 = ci * 128, ch0 = g * 768 + cb * 256;
        if (GATE_DB && k + 1 < upw) { GT_DECODE(k + 1, cin, cbn); GT_LOAD(ureg[Q], U, cin, cbn); }
        if (cb != 0 && pn_live) {
#pragma unroll
            for (int sl = 0; sl < 8; ++sl) { sn1 += pn[sl].x; sn2 += pn[sl].y; }
            pn_live = false; }
        if (ci != ci_cur) {
            { const int row = tid & 127, qq = tid >> 7; float a1 = 0.f, a2 = 0.f;
              if (k == 0) { const GAS f32x2_t* pp = (const GAS f32x2_t*)part + (size_t)(24 * qq) * M + m0 + row;
#pragma unroll 8
                  for (int sl = 0; sl < 24; ++sl) { const f32x2_t v = pp[(size_t)sl * M]; a1 += v.x; a2 += v.y; } }
              else { a1 = sn1; a2 = sn2;
#pragma unroll
                  for (int sl = 0; sl < 8; ++sl) { a1 += pn[sl].x; a2 += pn[sl].y; }
                  pn_live = false; }
              sn1 = 0.f; sn2 = 0.f;
              sql[(qq * 128 + row) * 2] = a1; sql[(qq * 128 + row) * 2 + 1] = a2; }
            LDS_BARRIER();
            if (tid < 128) { float a1 = 0.f, a2 = 0.f;
#pragma unroll
                for (int qq = 0; qq < 4; ++qq) { a1 += sql[(qq * 128 + tid) * 2]; a2 += sql[(qq * 128 + tid) * 2 + 1]; }
                const float mean = a1 * (1.0f / GH), var = a2 * (1.0f / GH) - mean * mean; stl[2 * tid] = mean; stl[2 * tid + 1] = rsqrtf(fmaxf(var, 0.f) + EPS); }
            LDS_BARRIER();
            ci_cur = ci;
        }
        {
            const f32x4 ga = lnw[0], gb = lnw[1], ba = lnw[2], bb = lnw[3];
            const float gg[8] = {ga.x, ga.y, ga.z, ga.w, gb.x, gb.y, gb.z, gb.w}, bb8[8] = {ba.x, ba.y, ba.z, ba.w, bb.x, bb.y, bb.z, bb.w};
#pragma unroll
            for (int ps = 0; ps < 8; ++ps) { const int s = rg + 16 * ps; const float mu = stl[2 * s], rstd = stl[2 * s + 1];
                float f[8]; unpack8(vreg[0][ps], f);
#pragma unroll
                for (int kk = 0; kk < 8; ++kk) f[kk] = (f[kk] - mu) * rstd * gg[kk] + bb8[kk];
                LAS unsigned char* wp = lds + OFF_VT + s * VTP + vpos * 2;
                *(LAS v2u*)wp = (v2u){pkbf(f[0], f[1]), pkbf(f[2], f[3])}; *(LAS v2u*)(wp + 16) = (v2u){pkbf(f[4], f[5]), pkbf(f[6], f[7])}; }
        }
        LDS_BARRIER();
        if (k + 1 < upw) { GT_DECODE(k + 1, ci2, cb2); GT_LOADV(vreg[0], V, ci2, cb2); GT_LNW(cb2); }
        if (k + 3 - cb < upw) {
            const GAS f32x2_t* pp = (const GAS f32x2_t*)part + (size_t)(24 * (tid >> 7) + 8 * cb) * M + m0 + 128 + (tid & 127);
#pragma unroll
            for (int sl = 0; sl < 8; ++sl) pn[sl] = pp[(size_t)sl * M];
            pn_live = true; }
        f32x16 acc[2][2];
#pragma unroll
        for (int dt = 0; dt < 2; ++dt)
#pragma unroll
            for (int tt = 0; tt < 2; ++tt) acc[dt][tt] = zero16();
        auto mix_steps = [&](auto THC) { constexpr int TH = decltype(THC)::value, NKS = (64 * TH + 63) / 16 + 1;
#pragma unroll
            for (int ks = 0; ks < NKS; ++ks) {
                bf16x8 af[2], bfr[2];
#pragma unroll
                for (int dt = 0; dt < 2; ++dt) af[dt] = cat8(tr_rd(vt_rd + (16 * ks) * VTP + dt * 64), tr_rd(vt_rd + (16 * ks + 4) * VTP + dt * 64));
#pragma unroll
                for (int tt = 0; tt < 2; ++tt) bfr[tt] = *(LAS const bf16x8*)(ws_rd + (32 * tt) * WSP + 32 * ks);
#pragma unroll
                for (int dt = 0; dt < 2; ++dt)
#pragma unroll
                    for (int tt = 0; tt < 2; ++tt) if (16 * ks <= 64 * TH + 32 * tt + 31) acc[dt][tt] = MFMA32(af[dt], bfr[tt], acc[dt][tt]); }
        };
        if (th == 0) mix_steps(IC0{}); else mix_steps(IC1{});
        LDS_BARRIER();
#pragma unroll
        for (int dt = 0; dt < 2; ++dt)
#pragma unroll
            for (int tt = 0; tt < 2; ++tt) { float o[16];
#pragma unroll
                for (int i = 0; i < 16; ++i) o[i] = acc[dt][tt][i] + bsv[tt];
                LAS unsigned char* mp = lds + OFF_VT + (64 * th + 32 * tt + l31) * MXP + (64 * dq + 32 * dt + 16 * h) * 2;
                v4u w0, w1; w0.x = pkbf(o[0], o[1]); w0.y = pkbf(o[2], o[3]); w0.z = pkbf(o[4], o[5]); w0.w = pkbf(o[6], o[7]); w1.x = pkbf(o[8], o[9]); w1.y = pkbf(o[10], o[11]); w1.z = pkbf(o[12], o[13]); w1.w = pkbf(o[14], o[15]);
                *(LAS v4u*)mp = w0; *(LAS v4u*)(mp + 16) = w1; }
        LDS_BARRIER();
        {
            bf16* up = DUMMY_OUT ? dummy + (size_t)((m0 + rg) & 4095) * GH + ch0 + 8 * dchunk : U + (size_t)(m0 + rg) * GH + ch0 + 8 * dchunk;
#pragma unroll
            for (int ps = 0; ps < 8; ++ps) { const v4u mw = *(LAS const v4u*)(lds + OFF_VT + (rg + 16 * ps) * MXP + dchunk * 16); float mf[8], uf[8], o[8]; unpack8(mw, mf); unpack8(ureg[P][ps], uf);
#pragma unroll
                for (int kk = 0; kk < 8; ++kk) o[kk] = uf[kk] * mf[kk];
                *(GAS v4u*)(up + (size_t)(16 * ps) * GH) = pack8(o); }
        }
        if (!GATE_DB && k + 1 < upw) { GT_DECODE(k + 1, ci3, cb3); GT_LOAD(ureg[Q], U, ci3, cb3); }
        LDS_BARRIER();
    };
    for (int k = 0; k < upw; k += 2) { unit_body(k, IC0{}); if (k + 1 < upw) unit_body(k + 1, IC1{}); }
#undef GT_DECODE
#undef GT_LOAD
#undef GT_LOADV
#undef GT_LNW
}

__device__ __forceinline__ unsigned offb(unsigned row, unsigned ch) { return 256u * row + 16u * (ch ^ (((row & 3u) << 2) | ((row >> 2) & 3u))); }
#ifndef RET_GP
#define RET_GP false
#endif
#ifdef PROBE_RAB
#define RET_GP_DECL , const bool GP = false
#define RET_GP_T
#else
#define RET_GP_DECL
#define RET_GP_T , bool GP = RET_GP
#endif
constexpr int RPS = 256;
template <bool STORE = true, bool DO_S = true, bool EXT_P = false RET_GP_T> __device__ __forceinline__ void retention_phase(LAS unsigned char* lds, int vcu, int G, int tid, const bf16* proj, bf16* oraw, float* ssp, const bf16* Pbuf = nullptr RET_GP_DECL) {
    constexpr int OFF_Q = 0, OFF_K = 32768, OFF_V = 65536, VP = 192, OFF_R = OFF_V + 128 * VP, RP = 528, PP = 272;
    static_assert(OFF_R + 64 * RP <= RING_BYTES && 128 * PP <= OFF_V, "retention LDS map");
    const int lane = tid & 63, wid = __builtin_amdgcn_readfirstlane(tid >> 6), wh = wid >> 1, wl = wid & 1;
    const int l31 = lane & 31, h = lane >> 5, blk = (lane >> 4) & 1, q = (lane & 15) >> 2, p = lane & 3;
    const int qch = tid & 15, qr = tid >> 4;
    const int vch = tid & 7, vr = tid >> 3;
    const int vpos = 32 * (vch >> 2) + 16 * (vch & 1) + 4 * ((vch & 3) >> 1);
    const unsigned xsw = (((unsigned)l31 & 3u) << 2) | (((unsigned)l31 >> 2) & 3u);
    const unsigned kfA_c = OFF_K + 256u * (32u * wh + l31) + 16u * ((unsigned)h ^ xsw);
    const unsigned q0A_c = OFF_Q + 256u * (64u * wl + l31) + 16u * ((unsigned)h ^ xsw);
    const unsigned rfA = OFF_R + (32u * wl + l31) * RP + 16u * h;
    const unsigned ccK = 4u * wh + 2u * blk + ((unsigned)p >> 1);
    const unsigned katA = OFF_K + 256u * (8u * h + q) + 16u * (ccK ^ ((((unsigned)q) << 2) | (2u * h))) + 8u * (p & 1);
    const unsigned katB = OFF_K + 256u * (8u * h + q + 4u) + 16u * (ccK ^ ((((unsigned)q) << 2) | (2u * h + 1u))) + 8u * (p & 1);
    const unsigned vtA = OFF_V + (8u * h + q) * VP + (32u * wl + 16u * blk + 4u * p) * 2u;
    const unsigned pfA = (32u * wh + l31) * PP + 16u * h;
    for (int unit = vcu; unit < 256; unit += G) {
        const int bh = unit >> 3, sl = unit & 7, b = bh >> 3, hd = bh & 7;
        const float lg = log1pf(-exp2f(-5.0f - (float)hd));
        const float cd = expf(128.0f * lg);
        const float vsc0 = expf((float)(127 - vr) * lg), vsc1 = expf((float)(63 - vr) * lg);
        const float sI = expf((float)(32 * wh + l31 - 127) * lg), sX = expf((float)(32 * wh + l31 + 1) * lg);
        const bf16* qg = proj + (size_t)hd * M * RPS + (size_t)(b * SEQ) * RPS; const bf16* kg = proj + (size_t)(8 + hd) * M * RPS + (size_t)(b * SEQ) * RPS;
        const unsigned vlo = (unsigned)(vr * 64 + 8 * vch);
        const bf16* vg = proj + (size_t)(16 + 2 * hd + (sl >> 2)) * M * RPS + (size_t)(sl & 3) * M * 64 + (size_t)(b * SEQ) * 64;
        for (int i = tid; i < 64 * RP / 16; i += NWAVES * 64) ((LAS v4u*)(lds + OFF_R))[i] = (v4u){0u, 0u, 0u, 0u};
        f32x16 Racc[2] = {zero16(), zero16()}, X = zero16();
        v4u qreg[4], kreg[4], vreg[2], preg[4];
#pragma unroll
        for (int i = 0; i < 4; ++i) { qreg[i] = *(const GAS v4u*)(qg + (size_t)(qr + 32 * i) * RPS + 8 * qch); kreg[i] = *(const GAS v4u*)(kg + (size_t)(qr + 32 * i) * RPS + 8 * qch); }
#pragma unroll
        for (int i = 0; i < 2; ++i) vreg[i] = *(const GAS v4u*)((vg + (size_t)(64 * i) * 64) + vlo);
        LAS v4u* gslot = (LAS v4u*)(lds + TAIL_OFF + tid * 32);
        const bf16* ggs = proj + (size_t)(32 + 2 * hd + (sl >> 2)) * M * RPS + (size_t)(sl & 3) * M * 64 + (size_t)(b * SEQ) * 64;
        const unsigned ggo = (unsigned)((32 * wh + l31) * 64 + 32 * wl + 16 * h);
#define ggp (ggs + ggo)
        v4u gq0, gq1; if (GP) { gq0 = ((const GAS v4u*)ggp)[0]; gq1 = ((const GAS v4u*)ggp)[1]; }
        LDS_BARRIER();
        for (int ci = 0; ci < 32; ++ci) {
            const int m0 = b * SEQ + ci * 128;
            f32x16 S[2] = {zero16(), zero16()};
#pragma unroll
            for (int st = 0; st < 2; ++st) {
#pragma unroll
                for (int i = 0; i < 4; ++i) { *(LAS v4u*)(lds + OFF_Q + offb(qr + 32 * i, qch)) = qreg[i]; *(LAS v4u*)(lds + OFF_K + offb(qr + 32 * i, qch)) = kreg[i]; }
                if (st == 0) {
                    if (GP) { gslot[0] = gq0; gslot[1] = gq1; }
#pragma unroll
                    for (int i = 0; i < 2; ++i) { const int s = vr + 64 * i; const float sc = i ? vsc1 : vsc0; float f[8]; unpack8(vreg[i], f);
#pragma unroll
                        for (int k = 0; k < 8; ++k) f[k] *= sc;
                        LAS unsigned char* wp = lds + OFF_V + s * VP + vpos * 2;
                        *(LAS v2u*)wp = (v2u){pkbf(f[0], f[1]), pkbf(f[2], f[3])}; *(LAS v2u*)(wp + 16) = (v2u){pkbf(f[4], f[5]), pkbf(f[6], f[7])}; }
                }
                if (EXT_P && st == 0) { const bf16* pg_ = Pbuf + ((size_t)(bh * 32 + ci)) * 16384 + (size_t)qr * 128 + 8 * qch;
#pragma unroll
                    for (int i = 0; i < 4; ++i) preg[i] = *(const GAS v4u*)(pg_ + (size_t)(32 * i) * 128); }
                { const int cn = (st == 0) ? ci : ci + 1, dk0 = (st == 0) ? 128 : 0;
                  if (cn < 32) {
#pragma unroll
                      for (int i = 0; i < 4; ++i) { qreg[i] = *(const GAS v4u*)(qg + (size_t)(cn * 128 + qr + 32 * i) * RPS + dk0 + 8 * qch); kreg[i] = *(const GAS v4u*)(kg + (size_t)(cn * 128 + qr + 32 * i) * RPS + dk0 + 8 * qch); }
                      if (st == 1) {
#pragma unroll
                          for (int i = 0; i < 2; ++i) vreg[i] = *(const GAS v4u*)((vg + (size_t)(cn * 128 + 64 * i) * 64) + vlo); } } }
                LDS_BARRIER();
#pragma unroll
                for (int i = 0; i < 16; ++i) Racc[st][i] *= cd;
#define RT_LOAD(F, ks_) do { const unsigned kx = (unsigned)(ks_) << 5; \
                    if (DO_S) { F.kf = *(LAS const bf16x8*)(lds + (kfA ^ kx)); F.q0 = *(LAS const bf16x8*)(lds + (q0A ^ kx)); F.q1 = *(LAS const bf16x8*)(lds + (q0A ^ kx) + 8192); } \
                    F.rf = *(LAS const bf16x8*)(lds + rfA + (128 * st + 16 * (ks_)) * 2); F.qx = *(LAS const bf16x8*)(lds + (kfA ^ kx) - (OFF_K - OFF_Q)); \
                    F.ka = cat8(tr_rd(lds + katA + 4096 * (ks_)), tr_rd(lds + katB + 4096 * (ks_))); F.vb = cat8(tr_rd(lds + vtA + 16 * VP * (ks_)), tr_rd(lds + vtA + 16 * VP * (ks_) + 4 * VP)); } while (0)
#define RT_MMA(F) do { if (DO_S) { S[0] = MFMA32(F.kf, F.q0, S[0]); S[1] = MFMA32(F.kf, F.q1, S[1]); } X = MFMA32(F.rf, F.qx, X); Racc[st] = MFMA32(F.ka, F.vb, Racc[st]); } while (0)
                { struct Fr { bf16x8 kf, q0, q1, rf, qx, ka, vb; } fa, fb;
                  unsigned kfA = kfA_c, q0A = q0A_c; asm volatile("" : "+v"(kfA), "+v"(q0A));
                  RT_LOAD(fa, 0);
#pragma unroll
                  for (int ks = 0; ks < 8; ks += 2) {
                      RT_LOAD(fb, ks + 1); __builtin_amdgcn_sched_barrier(0);
                      RT_MMA(fa); __builtin_amdgcn_sched_barrier(0);
                      if (ks + 2 < 8) { RT_LOAD(fa, ks + 2); } __builtin_amdgcn_sched_barrier(0);
                      RT_MMA(fb); __builtin_amdgcn_sched_barrier(0);
                  } }
#undef RT_LOAD
#undef RT_MMA
                LDS_BARRIER();
            }
#pragma unroll
            for (int jj = 0; jj < 2; ++jj) { if (EXT_P) break; const int c = 64 * wl + 32 * jj + l31;
#pragma unroll
                for (int g4 = 0; g4 < 4; ++g4) { const int s0 = 32 * wh + 8 * g4 + 4 * h; float f[4];
#pragma unroll
                    for (int e = 0; e < 4; ++e) f[e] = (c >= s0 + e) ? S[jj][4 * g4 + e] : 0.f;
                    *(LAS v2u*)(lds + c * PP + s0 * 2) = (v2u){pkbf(f[0], f[1]), pkbf(f[2], f[3])}; } }
            if (EXT_P) {
#pragma unroll
                for (int i = 0; i < 4; ++i) *(LAS v4u*)(lds + (qr + 32 * i) * PP + qch * 16) = preg[i]; }
#pragma unroll
            for (int st = 0; st < 2; ++st)
#pragma unroll
                for (int g4 = 0; g4 < 4; ++g4) { const int dk0 = 128 * st + 32 * wh + 8 * g4 + 4 * h;
                    *(LAS v2u*)(lds + OFF_R + (32 * wl + l31) * RP + dk0 * 2) = (v2u){pkbf(Racc[st][4 * g4], Racc[st][4 * g4 + 1]), pkbf(Racc[st][4 * g4 + 2], Racc[st][4 * g4 + 3])}; }
            LDS_BARRIER();
            f32x16 I = zero16();
            v4u g0, g1; if (GP) { g0 = gslot[0]; g1 = gslot[1]; } else { const GAS v4u* gp_ = (const GAS v4u*)(ggp + (size_t)(ci * 128) * 64); g0 = gp_[0]; g1 = gp_[1]; }
            { bf16x8 va0, pf0, va1, pf1;
#define PV_LOAD(VA, PF, ks_) do { VA = cat8(tr_rd(lds + vtA + 16 * VP * (ks_)), tr_rd(lds + vtA + 16 * VP * (ks_) + 4 * VP)); PF = *(LAS const bf16x8*)(lds + pfA + 32 * (ks_)); } while (0)
              PV_LOAD(va0, pf0, 0);
#pragma unroll
              for (int ks = 0; ks < 8; ks += 2) {
                  PV_LOAD(va1, pf1, ks + 1); __builtin_amdgcn_sched_barrier(0);
                  I = MFMA32(va0, pf0, I); __builtin_amdgcn_sched_barrier(0);
                  if (ks + 2 < 8) { PV_LOAD(va0, pf0, ks + 2); } __builtin_amdgcn_sched_barrier(0);
                  I = MFMA32(va1, pf1, I); __builtin_amdgcn_sched_barrier(0);
              }
#undef PV_LOAD
            }
            { const int c = 32 * wh + l31; float o[16], gv[16]; float sq = 0.f;
              { float a8[8], b8[8]; unpack8(g0, a8); unpack8(g1, b8);
#pragma unroll
                for (int i = 0; i < 8; ++i) { gv[i] = a8[i]; gv[8 + i] = b8[i]; } }
#pragma unroll
              for (int i = 0; i < 16; ++i) { o[i] = sI * I[i] + sX * X[i]; sq += o[i] * o[i]; o[i] *= silu_f(gv[i]); }
              sq += __builtin_bit_cast(float, __builtin_amdgcn_ds_bpermute((int)(((unsigned)lane ^ 32u) << 2), __builtin_bit_cast(int, sq)));
              if (STORE && h == 0) ssp[((size_t)(2 * sl + wl) * 8 + hd) * M + m0 + c] = sq;
              GAS v4u* op = (GAS v4u*)(oraw + (size_t)(m0 + c) * RV + hd * 512 + sl * 64 + 32 * wl + 16 * h);
              v4u w0, w1; w0.x = pkbf(o[0], o[1]); w0.y = pkbf(o[2], o[3]); w0.z = pkbf(o[4], o[5]); w0.w = pkbf(o[6], o[7]); w1.x = pkbf(o[8], o[9]); w1.y = pkbf(o[10], o[11]); w1.z = pkbf(o[12], o[13]); w1.w = pkbf(o[14], o[15]);
              if (STORE) { op[0] = w0; op[1] = w1; } else { asm volatile("" :: "v"(w0), "v"(w1)); } X = zero16(); }
            if (GP) { const GAS v4u* gn_ = (const GAS v4u*)(ggp + (size_t)((ci + 1 < 32 ? ci + 1 : ci) * 128) * 64); gq0 = gn_[0]; gq1 = gn_[1]; }
            LDS_BARRIER();
        }
    }
}

#undef ggp
__device__ __forceinline__ void ret_scores_phase(LAS unsigned char* lds, int vcu, int G, int tid, const bf16* proj, bf16* Pbuf) {
    const int lane = tid & 63, wid = __builtin_amdgcn_readfirstlane(tid >> 6), wh = wid >> 1, wl = wid & 1;
    const int l31 = lane & 31, h = lane >> 5;
    const int qch = tid & 15, qr = tid >> 4;
    const unsigned xsw = (((unsigned)l31 & 3u) << 2) | (((unsigned)l31 >> 2) & 3u);
    const unsigned kfA = 65536u + 256u * (32u * wh + l31) + 16u * ((unsigned)h ^ xsw);
    const unsigned q0A = 256u * (64u * wl + l31) + 16u * ((unsigned)h ^ xsw);
    for (int unit = vcu; unit < 1024; unit += G) {
        const int bh = unit >> 5, ci = unit & 31, b = bh >> 3, hd = bh & 7;
        const bf16* qg = proj + (size_t)(b * SEQ + ci * 128) * RPROJ + hd * 256; const bf16* kg = qg + 2048;
        v4u qreg[2][4], kreg[2][4];
#pragma unroll
        for (int hf = 0; hf < 2; ++hf)
#pragma unroll
            for (int i = 0; i < 4; ++i) { qreg[hf][i] = *(const GAS v4u*)(qg + (size_t)(qr + 32 * i) * RPROJ + 128 * hf + 8 * qch); kreg[hf][i] = *(const GAS v4u*)(kg + (size_t)(qr + 32 * i) * RPROJ + 128 * hf + 8 * qch); }
#pragma unroll
        for (int hf = 0; hf < 2; ++hf)
#pragma unroll
            for (int i = 0; i < 4; ++i) { *(LAS v4u*)(lds + 32768 * hf + offb(qr + 32 * i, qch)) = qreg[hf][i]; *(LAS v4u*)(lds + 65536 + 32768 * hf + offb(qr + 32 * i, qch)) = kreg[hf][i]; }
        LDS_BARRIER();
        f32x16 S[2] = {zero16(), zero16()};
#pragma unroll
        for (int hf = 0; hf < 2; ++hf)
#pragma unroll 4
            for (int ks = 0; ks < 8; ++ks) { const unsigned kx = (unsigned)ks << 5;
                const bf16x8 kf = *(LAS const bf16x8*)(lds + 32768 * hf + (kfA ^ kx)), q0 = *(LAS const bf16x8*)(lds + 32768 * hf + (q0A ^ kx)), q1 = *(LAS const bf16x8*)(lds + 32768 * hf + (q0A ^ kx) + 8192);
                S[0] = MFMA32(kf, q0, S[0]); S[1] = MFMA32(kf, q1, S[1]); }
        bf16* pg = Pbuf + (size_t)unit * 16384;
#pragma unroll
        for (int jj = 0; jj < 2; ++jj) { const int c = 64 * wl + 32 * jj + l31;
#pragma unroll
            for (int g4 = 0; g4 < 4; ++g4) { const int s0 = 32 * wh + 8 * g4 + 4 * h; float f[4];
#pragma unroll
                for (int e = 0; e < 4; ++e) f[e] = (c >= s0 + e) ? S[jj][4 * g4 + e] : 0.f;
                *(GAS v2u*)(pg + (size_t)c * 128 + s0) = (v2u){pkbf(f[0], f[1]), pkbf(f[2], f[3])}; } }
        LDS_BARRIER();
    }
}
struct Args { const void* in[18]; float* out; unsigned char* ws; int ph_lo, ph_hi; };
constexpr int N_PHASES = 19;
__global__ void __launch_bounds__(NWAVES * 64, 2) mega_fwd(Args args) {
    extern __shared__ __attribute__((aligned(16))) unsigned char lds_raw[];
    LAS unsigned char* lds = (LAS unsigned char*)lds_raw;
    volatile LAS unsigned* MISC = (volatile LAS unsigned*)(lds + MISC_OFF);
    const int tid = threadIdx.x, lane = tid & 63, wave = __builtin_amdgcn_readfirstlane(tid >> 6);
    const int G = gridDim.x, bx = blockIdx.x, vcu = (G % 8 == 0) ? (bx % 8) * (G / 8) + bx / 8 : bx;
    const int gw = vcu * NWAVES + wave, NGW = G * NWAVES;
    unsigned char* ws = args.ws;
    gu32* ctl = (gu32*)(ws + WS_CTL);
    for (int u = tid; u < (LDS_BYTES - LDSCTL_OFF) / 4; u += NWAVES * 64) ((LAS unsigned*)(lds + LDSCTL_OFF))[u] = 0u;
    __syncthreads();
    XcdBarrier bar = xcd_barrier_post((unsigned*)(ctl + CW_BAR), MISC + 8);
    const float* x = (const float*)args.in[0]; const int* positions = (const int*)args.in[1];
    const float* mix_pre_g = (const float*)args.in[2]; const float* mix_post_g = (const float*)args.in[3];
    const float* gmlp_w_in = (const float*)args.in[4]; const float* gmlp_ln_g = (const float*)args.in[5]; const float* gmlp_ln_b = (const float*)args.in[6];
    const float* gmlp_w_s = (const float*)args.in[7]; const float* gmlp_b_s = (const float*)args.in[8]; const float* gmlp_w_out = (const float*)args.in[9];
    const float* ret_w_in = (const float*)args.in[10]; const float* ret_w_out = (const float*)args.in[11];
    const float* ffn_pre_g = (const float*)args.in[12]; const float* ffn_post_g = (const float*)args.in[13];
    const float* ffn_w_up = (const float*)args.in[14]; const float* ffn_conv_w = (const float*)args.in[15]; const float* ffn_conv_b = (const float*)args.in[16]; const float* ffn_w_down = (const float*)args.in[17];
    float* out = args.out;
    bf16* WA = (bf16*)(ws + WS_WA); bf16* WB = (bf16*)(ws + WS_WB); bf16* HN = (bf16*)(ws + WS_HN); bf16* BIG = (bf16*)(ws + WS_BIG); bf16* H2 = (bf16*)(ws + WS_H2);
    bf16* XB = (bf16*)out; bf16* XB3 = BIG + (size_t)32 * MiB; float* RS = (float*)(ws + WS_STATS + ST_SS);
    float* st_s1 = (float*)(ws + WS_STATS + ST_S1); float* st_s2 = (float*)(ws + WS_STATS + ST_S2);
    const int lo = args.ph_lo, hi = args.ph_hi;
#define IN(k) (lo <= (k) && (k) < hi)
#ifndef DOUBLE_MASK
#define DOUBLE_MASK 0
#endif
#define REP(k) _Pragma("unroll") for (int rep_ = 0; rep_ < 1 + ((DOUBLE_MASK >> (k)) & 1); ++rep_) if ((rep_ ? (__syncthreads(), 0) : 0), true)
#ifdef PROBE_CLOCK
    unsigned long long pc_t0 = 0, pc_r0 = 0;
#define PCLK_BEGIN(k) do { if ((k) == PROBE_PH && bx == PROBE_CLOCK && tid == 0) { pc_t0 = __builtin_amdgcn_s_memtime(); pc_r0 = __builtin_amdgcn_s_memrealtime(); } } while (0)
#define PCLK_END(k) do { if ((k) == PROBE_PH && bx == PROBE_CLOCK && tid == 0) { const unsigned long long t1 = __builtin_amdgcn_s_memtime(), r1 = __builtin_amdgcn_s_memrealtime(); const float ghz = (float)(t1 - pc_t0) / (float)(r1 - pc_r0) * 0.1f; const float cyc = (float)(t1 - pc_t0); const float us = (float)(r1 - pc_r0) * 0.01f; \
        const float val = (PROBE_KIND == 0) ? ghz : (PROBE_KIND == 1) ? cyc : us; \
        __hip_atomic_store((float*)(ctl + CW_DBG), (val > PROBE_THR) ? 10.0f : 0.0f, __ATOMIC_RELAXED, __HIP_MEMORY_SCOPE_AGENT); } } while (0)
#else
#define PCLK_BEGIN(k) do { } while (0)
#define PCLK_END(k) do { } while (0)
#endif
#define OPQ_LANE() ({ int tq_ = tid; asm volatile("" : "+v"(tq_)); tq_ & 63; })
#define SEAM(k) do { PCLK_END(k); if (IN(k) && IN((k) + 1)) xcd_barrier(bar); } while (0)
#define SEAM2(k) do { PCLK_END(k); if (IN(k) && IN((k) + 2)) xcd_barrier(bar); } while (0)
#ifndef KNOB_ALIGN
#define KNOB_ALIGN true
#endif
#ifndef KNOB_SP2
#define KNOB_SP2 true
#endif
#ifndef KNOB_EB
#define KNOB_EB 0
#endif
#ifndef KNOB_CG4
#define KNOB_CG4 1
#endif
#if KNOB_CG4
typedef pg8::EpiConvGate4 EpiCG;
#else
typedef pg8::EpiConvGate EpiCG;
#endif
#ifndef KNOB_BAL
#define KNOB_BAL false
#endif
#ifdef PROBE_NOSTORE
#define GEMM(EPI, Aptr, Bptr, Nn, Kk, Eobj) do { pg8::Gemm g_{(const pg8::bf16_t*)(Aptr), (const pg8::bf16_t*)(Bptr), M, (Nn), (Kk)}; pg8::StaticOrder S_; S_.init(M, (Nn), G, bx); \
        if (rep_ == 0) pg8::gemm_phase<EPI, pg8::StaticOrder, true, true>(lds, g_, S_, (Eobj)); else { pg8::EpiNull En_; pg8::gemm_phase<pg8::EpiNull, pg8::StaticOrder, true, true>(lds, g_, S_, En_); } } while (0)
#else
#define GEMM(EPI, Aptr, Bptr, Nn, Kk, Eobj) do { pg8::Gemm g_{(const pg8::bf16_t*)(Aptr), (const pg8::bf16_t*)(Bptr), M, (Nn), (Kk)}; pg8::StaticOrder S_; S_.init(M, (Nn), G, bx); \
        pg8::gemm_phase<EPI, pg8::StaticOrder, (EPI::NEEDS_ALIGN || KNOB_ALIGN), KNOB_SP2, KNOB_BAL, KNOB_EB>(lds, g_, S_, (Eobj)); } while (0)
#endif

    PCLK_BEGIN(0);
#ifdef PROBE_CVT2
#define CVT_REPEAT int nr2_ = 2; asm volatile("" : "+s"(nr2_)); _Pragma("unroll 1") for (int r2_ = 0; r2_ < nr2_; ++r2_)
#else
#define CVT_REPEAT
#endif
#ifdef CVT_STAGB
#define CVT_PRE(ILV, W, Kk, Nn, WT) do { int tq_ = tid; asm volatile("" : "+v"(tq_)); convert_weight_stagb<ILV>((W), (Kk), (Nn), (WT), lds, bx, G, tq_, 0); } while (0)
#define CVT_POST(ILV, W, Kk, Nn, WT) do { __syncthreads(); int tq_ = tid; asm volatile("" : "+v"(tq_)); convert_weight_stagb<ILV>((W), (Kk), (Nn), (WT), lds, bx, G, tq_, 1); } while (0)
#define CVT_PRE_G(ILV, W, Kk, Nn, WT, Gk) do { int tq_ = tid; asm volatile("" : "+v"(tq_)); convert_weight_stagb<ILV, true>((W), (Kk), (Nn), (WT), lds, bx, G, tq_, 0, (Gk)); } while (0)
#define CVT_POST_G(ILV, W, Kk, Nn, WT, Gk) do { __syncthreads(); int tq_ = tid; asm volatile("" : "+v"(tq_)); convert_weight_stagb<ILV, true>((W), (Kk), (Nn), (WT), lds, bx, G, tq_, 1, (Gk)); } while (0)
#elif defined(CVT_STAG)
#define CVT_PRE(ILV, W, Kk, Nn, WT) do { int ln_ = lane; asm volatile("" : "+v"(ln_)); convert_weight_stag<ILV>((W), (Kk), (Nn), (WT), lds, bx, G, wave, ln_, 0); __syncthreads(); } while (0)
#define CVT_POST(ILV, W, Kk, Nn, WT) do { __syncthreads(); int ln_ = lane; asm volatile("" : "+v"(ln_)); convert_weight_stag<ILV>((W), (Kk), (Nn), (WT), lds, bx, G, wave, ln_, 1); } while (0)
#define CVT_PRE_G(ILV, W, Kk, Nn, WT, Gk) do { int ln_ = lane; asm volatile("" : "+v"(ln_)); convert_weight_stag<ILV, true>((W), (Kk), (Nn), (WT), lds, bx, G, wave, ln_, 0, (Gk)); __syncthreads(); } while (0)
#define CVT_POST_G(ILV, W, Kk, Nn, WT, Gk) do { __syncthreads(); int ln_ = lane; asm volatile("" : "+v"(ln_)); convert_weight_stag<ILV, true>((W), (Kk), (Nn), (WT), lds, bx, G, wave, ln_, 1, (Gk)); } while (0)
#else
#ifdef CVT_ALL_PRE
#define CVT_PRE(ILV, W, Kk, Nn, WT) do { { int ln_ = lane; asm volatile("" : "+v"(ln_)); CVT_REPEAT convert_weight_grp<ILV>((W), (Kk), (Nn), (WT), lds, (bx & 1), (bx >> 1) * NWAVES + wave, (G >> 1) * NWAVES, wave, ln_); __syncthreads(); } } while (0)
#else
#define CVT_PRE(ILV, W, Kk, Nn, WT) do { if (!(bx & 1)) { int ln_ = lane; asm volatile("" : "+v"(ln_)); CVT_REPEAT convert_weight_grp<ILV>((W), (Kk), (Nn), (WT), lds, 0, (bx >> 1) * NWAVES + wave, (G >> 1) * NWAVES, wave, ln_); __syncthreads(); } } while (0)
#endif
#ifdef CVT_ALL_PRE
#define CVT_POST(ILV, W, Kk, Nn, WT) do { } while (0)
#else
#define CVT_POST(ILV, W, Kk, Nn, WT) do { if (bx & 1) { __syncthreads(); int ln_ = lane; asm volatile("" : "+v"(ln_)); CVT_REPEAT convert_weight_grp<ILV>((W), (Kk), (Nn), (WT), lds, 1, (bx >> 1) * NWAVES + wave, (G >> 1) * NWAVES, wave, ln_); } } while (0)
#endif
#ifdef CVT_ALL_PRE
#define CVT_PRE_G(ILV, W, Kk, Nn, WT, Gk) do { { int ln_ = lane; asm volatile("" : "+v"(ln_)); CVT_REPEAT convert_weight_grp<ILV, true>((W), (Kk), (Nn), (WT), lds, (bx & 1), (bx >> 1) * NWAVES + wave, (G >> 1) * NWAVES, wave, ln_, (Gk)); __syncthreads(); } } while (0)
#else
#define CVT_PRE_G(ILV, W, Kk, Nn, WT, Gk) do { if (!(bx & 1)) { int ln_ = lane; asm volatile("" : "+v"(ln_)); CVT_REPEAT convert_weight_grp<ILV, true>((W), (Kk), (Nn), (WT), lds, 0, (bx >> 1) * NWAVES + wave, (G >> 1) * NWAVES, wave, ln_, (Gk)); __syncthreads(); } } while (0)
#endif
#ifdef CVT_ALL_PRE
#define CVT_POST_G(ILV, W, Kk, Nn, WT, Gk) do { } while (0)
#else
#define CVT_POST_G(ILV, W, Kk, Nn, WT, Gk) do { if (bx & 1) { __syncthreads(); int ln_ = lane; asm volatile("" : "+v"(ln_)); CVT_REPEAT convert_weight_grp<ILV, true>((W), (Kk), (Nn), (WT), lds, 1, (bx >> 1) * NWAVES + wave, (G >> 1) * NWAVES, wave, ln_, (Gk)); } } while (0)
#endif
#endif
    if (IN(0)) REP(0) {
        convert_weight(gmlp_w_in, D, GD, WA, lds, gw, NGW, wave, lane);
#ifdef PROBE_CAB
        { bf16* dummyW = BIG; __syncthreads(); const unsigned long long t0 = __builtin_amdgcn_s_memtime();
          if (CAB_A) cvt_blocks<false, false>(gmlp_w_in, D, GD, dummyW, lds, bx, (D / 64) * (GD / 256), G, tid); else convert_weight<false, 0>(gmlp_w_in, D, GD, dummyW, lds, gw, NGW, wave, lane);
          __syncthreads(); const unsigned long long t1 = __builtin_amdgcn_s_memtime();
          if (CAB_B) cvt_blocks<false, false>(gmlp_w_in, D, GD, dummyW, lds, bx, (D / 64) * (GD / 256), G, tid); else convert_weight<false, 0>(gmlp_w_in, D, GD, dummyW, lds, gw, NGW, wave, lane);
          __syncthreads(); const unsigned long long t2 = __builtin_amdgcn_s_memtime();
          if (tid == 0) { const float dA = (float)(t1 - t0), dB = (float)(t2 - t1); if (dB < dA * (1.0f - (AB_THR))) atomicAdd((unsigned*)(ctl + CW_DBG + 64), 1u); } }
#endif
        first_norm_phase(gw, NGW, lane, x, mix_pre_g, HN);
    }
    SEAM(0);
    PCLK_BEGIN(1);
#ifdef PROBE_EPI1
    if (IN(1)) REP(1) { pg8::Gemm g_{(const pg8::bf16_t*)HN, (const pg8::bf16_t*)WA, M, GD, D}; pg8::StaticOrder S_; S_.init(M, GD, G, bx);
        if (rep_ == 0) { pg8::EpiGeluSplit E{(pg8::bf16_t*)BIG, GH, GH, (size_t)M * GH, (float*)H2, M}; pg8::gemm_phase<pg8::EpiGeluSplit, pg8::StaticOrder, true, true>(lds, g_, S_, E); }
        else if (PROBE_EPI1 == 0) { pg8::EpiNull E; pg8::gemm_phase<pg8::EpiNull, pg8::StaticOrder, true, true>(lds, g_, S_, E); }
        else if (PROBE_EPI1 == 1) { pg8::EpiGeluSplit E{(pg8::bf16_t*)BIG, GH, GH, (size_t)M * GH, (float*)H2, M}; pg8::gemm_phase<pg8::EpiGeluSplit, pg8::StaticOrder, true, true>(lds, g_, S_, E); }
        else { pg8::EpiGeluSplitT<false> E{(pg8::bf16_t*)BIG, GH, GH, (size_t)M * GH, (float*)H2, M}; pg8::gemm_phase<pg8::EpiGeluSplitT<false>, pg8::StaticOrder, true, true>(lds, g_, S_, E); } }
#else
#ifdef PROBE_AB
    if (IN(1)) { int rep_ = 0; (void)rep_;
        CVT_PRE(false, gmlp_w_out, GH, D, WB); pg8::EpiGeluSplit E{(pg8::bf16_t*)BIG, GH, GH, (size_t)M * GH, (float*)H2, M, lds + TAIL_OFF};
        pg8::Gemm g_{(const pg8::bf16_t*)HN, (const pg8::bf16_t*)WA, M, GD, D}; pg8::StaticOrder S_; S_.init(M, GD, G, bx);
        pg8::gemm_phase<pg8::EpiGeluSplit, pg8::StaticOrder, true, KNOB_SP2, KNOB_BAL, 0>(lds, g_, S_, E);
        pg8::EpiNull En; pg8::StaticOrder Sa, Sb; Sa.init(M, GD, G, bx, AB_WGM_A); Sb.init(M, GD, G, bx, AB_WGM_B);
        __syncthreads(); const unsigned long long t0 = AB_CLOCK();
        pg8::gemm_phase<pg8::EpiNull, pg8::StaticOrder, true, KNOB_SP2, true, 0, 0, AB_VAR_A>(lds, g_, Sa, En);
        __syncthreads(); const unsigned long long t1 = AB_CLOCK();
        pg8::gemm_phase<pg8::EpiNull, pg8::StaticOrder, true, KNOB_SP2, true, 0, 0, AB_VAR_B>(lds, g_, Sb, En);
        __syncthreads(); const unsigned long long t2 = AB_CLOCK();
        if (tid == 0) { const float dA = (float)(t1 - t0), dB = (float)(t2 - t1); if (dB < dA * (1.0f - (AB_THR))) atomicAdd((unsigned*)(ctl + CW_DBG + 64), 1u); }
        CVT_POST(false, gmlp_w_out, GH, D, WB); }
#else
    if (IN(1)) REP(1) {
        if (KNOB_GELU_TAB) {
            for (int k = tid; k < pg8::GELU_TAB_N; k += NWAVES * 64) { const float a0 = (float)k * (1.0f / pg8::GELU_TAB_SCALE), a1 = (float)(k + 1) * (1.0f / pg8::GELU_TAB_SCALE);
                const float g0 = 0.5f * a0 * erfcf(a0 * 0.70710678118654752f), g1 = 0.5f * a1 * erfcf(a1 * 0.70710678118654752f);
                ((LAS float*)(lds + TAIL_OFF))[2 * k] = g0; ((LAS float*)(lds + TAIL_OFF))[2 * k + 1] = g1 - g0; }
            __syncthreads(); }
        CVT_PRE(false, gmlp_w_out, GH, D, WB); pg8::EpiGeluSplit E{(pg8::bf16_t*)BIG, GH, GH, (size_t)M * GH, (float*)H2, M, lds + TAIL_OFF}; GEMM(pg8::EpiGeluSplit, HN, WA, GD, D, E); CVT_POST(false, gmlp_w_out, GH, D, WB); }
#endif
#endif
    SEAM(1);
    PCLK_BEGIN(3);
    if (IN(3)) REP(3) {
#ifdef PROBE_GATE
        if (rep_ == 0) gating_phase(lds, vcu, G, tid, BIG, BIG + (size_t)M * GH, (const float*)H2, HN, gmlp_ln_g, gmlp_ln_b, gmlp_w_s, gmlp_b_s); else gating_phase<true>(lds, vcu, G, tid, BIG, BIG + (size_t)M * GH, (const float*)H2, HN, gmlp_ln_g, gmlp_ln_b, gmlp_w_s, gmlp_b_s);
#else
        gating_phase(lds, vcu, G, tid, BIG, BIG + (size_t)M * GH, (const float*)H2, HN, gmlp_ln_g, gmlp_ln_b, gmlp_w_s, gmlp_b_s);
#endif
    }
    SEAM(3);
    PCLK_BEGIN(4);
    if (IN(4)) REP(4) { CVT_PRE_G(true, ffn_w_up, D, FF2, WA, ffn_pre_g); pg8::EpiPlain E{(pg8::bf16_t*)HN, D}; GEMM(pg8::EpiPlain, BIG, WB, D, GH, E); CVT_POST_G(true, ffn_w_up, D, FF2, WA, ffn_pre_g); }
    SEAM(4);
    PCLK_BEGIN(5);
    if (IN(5)) REP(5) {
        resid_fold_phase<true, false>(gw, NGW, lane, HN, x, nullptr, XB, RS, mix_post_g);
    }
    SEAM(5);
    PCLK_BEGIN(6);
#ifdef PROBE_EPI6
    if (IN(6)) REP(6) { if (rep_ == 0) CVT_PRE(false, ffn_w_down, FF, D, WB); pg8::Gemm g_{(const pg8::bf16_t*)HN, (const pg8::bf16_t*)WA, M, FF2, D}; pg8::StaticOrder S_; S_.init(M, FF2, G, bx);
        if (rep_ == 0 || PROBE_EPI6 == 1) { pg8::EpiConvGate E{(pg8::bf16_t*)H2, FF, ffn_conv_w, ffn_conv_b, (float*)BIG, lds + TAIL_OFF, FF2, FF, (LAS float*)(lds + RTAB_OFF)}; pg8::gemm_phase<pg8::EpiConvGate, pg8::StaticOrder, true, true>(lds, g_, S_, E); }
        else { pg8::EpiNull E; pg8::gemm_phase<pg8::EpiNull, pg8::StaticOrder, true, true>(lds, g_, S_, E); }
        if (rep_ == 0) CVT_POST(false, ffn_w_down, FF, D, WB); }
#else
    if (IN(6)) REP(6) { CVT_PRE(false, ffn_w_down, FF, D, WB); pg8::StaticOrder Soe; Soe.init(M, FF2, G, bx); EpiCG E{(pg8::bf16_t*)H2, FF, ffn_conv_w, ffn_conv_b, (float*)BIG, lds + TAIL_OFF, FF2, FF, (LAS float*)(lds + RTAB_OFF), Soe, 0}; GEMM(EpiCG, XB, WA, FF2, D, E); CVT_POST(false, ffn_w_down, FF, D, WB); }
#endif
    SEAM2(6);
    PCLK_BEGIN(8);
    if (IN(8)) REP(8) { { pg8::StaticOrder Sf; Sf.init(M, D, G, bx); pg8::Unit uf; int lastpm = -1; for (int i = 0; Sf.next(i, uf); ++i) if (uf.pm != lastpm) { ffn_fixup_local(tid, uf.pm, -1, (const float*)BIG, H2, ffn_conv_w, ffn_conv_b); lastpm = uf.pm; } }
        CVT_PRE_G(false, ret_w_in, D, RPROJ, WA, mix_pre_g + D); pg8::EpiPlain E{(pg8::bf16_t*)HN, D}; GEMM(pg8::EpiPlain, H2, WB, D, FF, E); CVT_POST_G(false, ret_w_in, D, RPROJ, WA, mix_pre_g + D); }
    SEAM(8);
    PCLK_BEGIN(9);
    if (IN(9)) REP(9) {
        resid_fold_phase<false, false>(gw, NGW, lane, HN, XB, RS, XB, RS, ffn_post_g);
    }
    SEAM(9);
    PCLK_BEGIN(10);
    if (IN(10)) REP(10) { CVT_PRE(false, ret_w_out, RV, D, WB); pg8::EpiRetIn E{(pg8::bf16_t*)BIG, M, positions}; GEMM(pg8::EpiRetIn, XB, WA, RPROJ, D, E); CVT_POST(false, ret_w_out, RV, D, WB); }
    SEAM(10);
    PCLK_BEGIN(11);
    if (IN(11)) REP(11) {
#ifdef PROBE_RAB
        { unsigned long long ta = 0, tb = 0;
          _Pragma("unroll 1") for (int r2 = 0; r2 < 2; ++r2) { int fl = r2 ? (int)(RAB_B) : (int)(RAB_A); asm volatile("" : "+s"(fl));
              __syncthreads(); const unsigned long long tq = AB_CLOCK(); if (r2 == 0) ta = tq; else tb = tq;
              retention_phase<true, true, false>(lds, vcu, G, tid, BIG, H2, (float*)(H2 + (size_t)M * RV), nullptr, fl != 0); }
          __syncthreads(); const unsigned long long tc = AB_CLOCK();
          if (tid == 0) { const float dA = (float)(tb - ta), dB = (float)(tc - tb); if (dB < dA * (1.0f - (AB_THR))) atomicAdd((unsigned*)(ctl + CW_DBG + 64), 1u); } }
#elif defined(PROBE_RET)
        if (rep_ == 0) retention_phase(lds, vcu, G, tid, BIG, H2, (float*)(H2 + (size_t)M * RV)); else retention_phase<false, (PROBE_RET & 1) != 0>(lds, vcu, G, tid, BIG, H2, (float*)(H2 + (size_t)M * RV));
#else
        retention_phase(lds, vcu, G, tid, BIG, H2, (float*)(H2 + (size_t)M * RV));
#endif
    }
    SEAM(11);
    PCLK_BEGIN(13);
    if (IN(13)) REP(13) { { pg8::StaticOrder Sf; Sf.init(M, D, G, bx); pg8::Unit ua, ub; ub.pm = -1; Sf.next(0, ua); if (!Sf.next(1, ub)) ub.pm = -1; ret_scale_table((LAS float*)(lds + RTAB_OFF), tid, ua.pm, ub.pm, (const float*)(H2 + (size_t)M * RV)); }
        CVT_PRE_G(true, ffn_w_up + (size_t)D * FF2, D, FF2, WA, ffn_pre_g + D); pg8::EpiPlainKS E{(pg8::bf16_t*)HN, D, (const LAS float*)(lds + RTAB_OFF)}; GEMM(pg8::EpiPlainKS, H2, WB, D, RV, E); CVT_POST_G(true, ffn_w_up + (size_t)D * FF2, D, FF2, WA, ffn_pre_g + D); }
    SEAM(13);
    PCLK_BEGIN(14);
    if (IN(14)) REP(14) {
        resid_fold_phase<false, false>(gw, NGW, lane, HN, XB, RS, XB3, RS, mix_post_g + D);
    }
    SEAM(14);
    PCLK_BEGIN(15);
    if (IN(15)) REP(15) { CVT_PRE(false, ffn_w_down + (size_t)FF * D, FF, D, WB); pg8::StaticOrder Soe; Soe.init(M, FF2, G, bx); EpiCG E{(pg8::bf16_t*)H2, FF, ffn_conv_w + (size_t)3 * FF2, ffn_conv_b + FF2, (float*)BIG, lds + TAIL_OFF, FF2, FF, (LAS float*)(lds + RTAB_OFF), Soe, 0}; GEMM(EpiCG, XB3, WA, FF2, D, E); CVT_POST(false, ffn_w_down + (size_t)FF * D, FF, D, WB); }
    SEAM2(15);
    PCLK_BEGIN(17);
    if (IN(17)) REP(17) { { pg8::StaticOrder Sf; Sf.init(M, D, G, bx); pg8::Unit uf; int lastpm = -1; for (int i = 0; Sf.next(i, uf); ++i) if (uf.pm != lastpm) { ffn_fixup_local(tid, uf.pm, -1, (const float*)BIG, H2, ffn_conv_w + (size_t)3 * FF2, ffn_conv_b + FF2); lastpm = uf.pm; } }
        pg8::EpiPlain E{(pg8::bf16_t*)HN, D}; GEMM(pg8::EpiPlain, H2, WB, D, FF, E); }
    SEAM(17);
    PCLK_BEGIN(18);
    if (IN(18)) REP(18) { resid_fold_phase<false, true>(gw, NGW, lane, HN, XB3, RS, out, nullptr, ffn_post_g + D); }
#if defined(PROBE_AB) || defined(PROBE_RAB) || defined(PROBE_CAB)
    { xcd_barrier(bar); const unsigned votes = __hip_atomic_load((unsigned*)(ctl + CW_DBG + 64), __ATOMIC_RELAXED, __HIP_MEMORY_SCOPE_AGENT); const float sc = (votes * 2u > (unsigned)G) ? 1.5f : 1.0f;
      for (int m = gw; m < M; m += NGW) { GAS f32x4* xo = (GAS f32x4*)(out + (size_t)m * D); for (int j = lane; j < D / 4; j += 64) { f32x4 v = xo[j]; v = v * sc; xo[j] = v; } } }
#endif
#ifdef PROBE_CLOCK
    { const float sc = 1.0f + 0.1f * __hip_atomic_load((float*)(ctl + CW_DBG), __ATOMIC_RELAXED, __HIP_MEMORY_SCOPE_AGENT); asm volatile("s_waitcnt vmcnt(0)" ::: "memory");
      for (int m = gw; m < M; m += NGW) { GAS f32x4* xo = (GAS f32x4*)(out + (size_t)m * D); for (int j = lane; j < D / 4; j += 64) { f32x4 v = xo[j]; v = v * sc; xo[j] = v; } } }
#endif
#undef IN
#undef SEAM
#undef GEMM
}

extern "C" void kernel_launch(void* const* d_in, const int* in_sizes, int n_in, void* d_out, int out_size, void* d_ws, size_t ws_size, hipStream_t stream) {
    static int grid = 0;
    if (grid == 0) {
        if (n_in != 18 || in_sizes[0] != M * D || out_size != M * D || ws_size < WS_END) { fprintf(stderr, "kernel_launch: unexpected problem shape / workspace (n_in %d, in0 %d, out %d, ws %zu < %zu)\n", n_in, n_in > 0 ? in_sizes[0] : -1, out_size, ws_size, (size_t)WS_END); grid = -1; return; }
        int dev = 0, cus = 0, per_cu = 0;
        if (hipGetDevice(&dev) != hipSuccess || hipDeviceGetAttribute(&cus, hipDeviceAttributeMultiprocessorCount, dev) != hipSuccess) { fprintf(stderr, "kernel_launch: device query failed\n"); grid = -1; return; }
        if (hipFuncSetAttribute((const void*)mega_fwd, hipFuncAttributeMaxDynamicSharedMemorySize, LDS_BYTES) != hipSuccess) { fprintf(stderr, "kernel_launch: hipFuncSetAttribute failed\n"); grid = -1; return; }
        if (hipOccupancyMaxActiveBlocksPerMultiprocessor(&per_cu, (const void*)mega_fwd, NWAVES * 64, LDS_BYTES) != hipSuccess || per_cu < 1) fprintf(stderr, "kernel_launch: note: occupancy query reports %d workgroups per CU\n", per_cu);
        (void)hipGetLastError();
        grid = cus;
    }
    if (grid < 0) return;
    if (hipMemsetAsync((char*)d_ws, 0, ZERO_BYTES, stream) != hipSuccess) { fprintf(stderr, "kernel_launch: memset failed\n"); return; }
    Args a{};
    for (int i = 0; i < 18; ++i) a.in[i] = d_in[i];
    a.out = (float*)d_out; a.ws = (unsigned char*)d_ws; a.ph_lo = 0; a.ph_hi = N_PHASES;
    hipLaunchKernelGGL(mega_fwd, dim3(grid), dim3(NWAVES * 64), LDS_BYTES, stream, a);
    const hipError_t le = hipPeekAtLastError();
    if (le != hipSuccess) fprintf(stderr, "kernel_launch: launch failed: %s\n", hipGetErrorName(le));
}
```
